# Optimizing an MI355X kernel written in HIP

```python
import jax, jax.numpy as jnp
from jax import lax
import numpy as np

D_MODEL = 1024
BATCH = 4
SEQ = 4096
DEPTH = 1
DEC_BATCH = 128
DEC_SEQ = 8
PAST_LEN = 8192
PAGE_SIZE = 128

MIX_W = D_MODEL
ATT_W = MIX_W // 2
MLSTM_W = MIX_W - ATT_W
HEAD_DIM = 64
N_HEADS = ATT_W // HEAD_DIM
N_KV_HEADS = 2
GQA_GROUP = N_HEADS // N_KV_HEADS
KV_W = N_KV_HEADS * HEAD_DIM
WINDOW = 128
BLOCK = WINDOW
M_HEADS = 4
M_HEAD_DIM = MLSTM_W // M_HEADS
CONV_W = 4
N_META = 16
META_PAD = BLOCK - N_META
D_FF = -(-8 * D_MODEL // (3 * 256)) * 256
IN_SPLITS = (ATT_W, KV_W, KV_W, MLSTM_W, MLSTM_W, MLSTM_W, M_HEADS, M_HEADS)
IN_W = sum(IN_SPLITS)
ALIBI_SLOPES = tuple(2.0 ** (-8.0 * (h + 1) / N_HEADS) for h in range(N_HEADS))
DEEPNORM_ALPHA = (2.0 * DEPTH) ** 0.25
DEEPNORM_BETA = (8.0 * DEPTH) ** -0.25
EPS = 1e-5

kernel_name = 'hymba_swa_sink_mlstm_deepnorm_step'


def layer_norm(x, g, b):
    xf = x.astype(jnp.float32)
    mu = jnp.mean(xf, axis=-1, keepdims=True)
    var = jnp.mean(jnp.square(xf - mu), axis=-1, keepdims=True)
    y = (xf - mu) * lax.rsqrt(var + EPS) * g.astype(jnp.float32) + b.astype(jnp.float32)
    return y.astype(x.dtype)


def head_norm(h, g):
    hf = h.astype(jnp.float32)
    mu = jnp.mean(hf, axis=-1, keepdims=True)
    var = jnp.mean(jnp.square(hf - mu), axis=-1, keepdims=True)
    y = ((hf - mu) * lax.rsqrt(var + EPS)).reshape(h.shape[:-2] + (-1,))
    return (y * g.astype(jnp.float32)).astype(h.dtype)


def split_proj(x, w_in):
    z = x @ w_in
    bounds = np.cumsum(IN_SPLITS)[:-1].tolist()
    return jnp.split(z, bounds, axis=-1)


def causal_conv(ext, w_conv, b_conv):
    l = ext.shape[1] - (CONV_W - 1)
    y = b_conv
    for j in range(CONV_W):
        y = y + ext[:, j:j + l] * w_conv[j]
    return y


def swa_attend(q, k, v, key_valid, sinks):
    f32 = jnp.float32
    lq, lk = q.shape[2], k.shape[2]
    s = jnp.einsum('nbqkgd,nbskd->nbkgqs', q.astype(f32), k.astype(f32)) * (HEAD_DIM ** -0.5)
    dist = WINDOW + jnp.arange(lq)[:, None] - jnp.arange(lk)[None, :]
    band = (dist >= 0) & (dist < WINDOW)
    slopes = jnp.asarray(ALIBI_SLOPES, f32).reshape(N_KV_HEADS, GQA_GROUP)
    alibi = -slopes[:, :, None, None] * dist.astype(f32)
    mask = band[None] & key_valid[:, None, :]
    s = jnp.where(mask[None, :, None, None], s + alibi, -jnp.inf)
    sink = sinks.astype(f32).reshape(N_KV_HEADS, GQA_GROUP)[None, None, :, :, None, None]
    mx = jnp.maximum(jnp.max(s, axis=-1, keepdims=True), sink)
    p = jnp.exp(s - mx)
    p = p / (jnp.sum(p, axis=-1, keepdims=True) + jnp.exp(sink - mx))
    return jnp.einsum('nbkgqs,nbskd->nbqkgd', p, v.astype(f32)).astype(v.dtype)


def mlstm_inputs(c_act, vm, i_pre, f_pre, w_mq, w_mk, b_i, b_f):
    n, l, _ = c_act.shape
    ca = c_act.reshape(n, l, M_HEADS, M_HEAD_DIM)
    q = jnp.einsum('nlhd,hde->nhle', ca, w_mq)
    k = jnp.einsum('nlhd,hde->nhle', ca, w_mk) * (M_HEAD_DIM ** -0.5)
    v = vm.reshape(n, l, M_HEADS, M_HEAD_DIM).transpose(0, 2, 1, 3)
    logi = (i_pre + b_i).astype(jnp.float32).transpose(0, 2, 1)
    logf = jax.nn.log_sigmoid((f_pre + b_f).astype(jnp.float32)).transpose(0, 2, 1)
    return q, k, v, logi, logf


def mlstm_chunk(C_s, n_s, m_s, q, k, v, logi, logf):
    f32 = jnp.float32
    C_s, n_s, m_s = C_s.astype(f32), n_s.astype(f32), m_s.astype(f32)
    q, k, v = q.astype(f32), k.astype(f32), v.astype(f32)
    l = q.shape[-2]
    b = jnp.cumsum(logf, axis=-1)
    causal = jnp.tril(jnp.ones((l, l), bool))
    dmat = jnp.where(causal, b[..., :, None] - b[..., None, :] + logi[..., None, :], -jnp.inf)
    m_inter = b + m_s[..., None]
    m_t = jnp.maximum(m_inter, jnp.max(dmat, axis=-1))
    w_inter = jnp.exp(m_inter - m_t)
    sc = jnp.einsum('nhtk,nhsk->nhts', q, k) * jnp.exp(dmat - m_t[..., None])
    num = w_inter[..., None] * jnp.einsum('nhvk,nhtk->nhtv', C_s, q) + jnp.einsum('nhts,nhsv->nhtv', sc, v)
    den = w_inter * jnp.einsum('nhk,nhtk->nht', n_s, q) + jnp.sum(sc, axis=-1)
    h = num / jnp.maximum(jnp.abs(den), jnp.exp(-m_t))[..., None]
    m_end = m_t[..., -1]
    decay = jnp.exp(b[..., -1] + m_s - m_end)
    wk = jnp.exp(b[..., -1:] - b + logi - m_end[..., None])
    C_new = decay[..., None, None] * C_s + jnp.einsum('nhs,nhsv,nhsk->nhvk', wk, v, k)
    n_new = decay[..., None] * n_s + jnp.einsum('nhs,nhsk->nhk', wk, k)
    return h, (C_new, n_new, m_end)


def mix_and_ffn(x, att, h_m, o_pre, g_attn, g_mlstm, w_out, ln1_g, ln1_b, w_gate, w_up, w_down, ln2_g, ln2_b):
    o = jax.nn.sigmoid(o_pre).reshape(h_m.shape)
    y = jnp.concatenate([head_norm(att, g_attn), head_norm(o * h_m, g_mlstm)], axis=-1)
    x1 = layer_norm(DEEPNORM_ALPHA * x + y @ w_out, ln1_g, ln1_b)
    ffn = (jax.nn.silu(x1 @ w_gate) * (x1 @ w_up)) @ w_down
    return layer_norm(DEEPNORM_ALPHA * x1 + ffn, ln2_g, ln2_b)


def prompt_layer(x, valid, key_valid, w_in, w_conv, b_conv, w_mq, w_mk, b_i, b_f, attn_sinks,
                 g_attn, g_mlstm, w_out, ln1_g, ln1_b, w_gate, w_up, w_down, ln2_g, ln2_b):
    n, p, _ = x.shape
    nb = p // BLOCK
    q, k, v, c, vm, o_pre, i_pre, f_pre = split_proj(x, w_in)
    k = k.reshape(n, p, N_KV_HEADS, HEAD_DIM)
    v = v.reshape(n, p, N_KV_HEADS, HEAD_DIM)

    def band_blocks(t):
        tp = jnp.pad(t, ((0, 0), (BLOCK, 0), (0, 0), (0, 0))).reshape(n, nb + 1, BLOCK, N_KV_HEADS, HEAD_DIM)
        return jnp.concatenate([tp[:, :-1], tp[:, 1:]], axis=2)

    att = swa_attend(q.reshape(n, nb, BLOCK, N_KV_HEADS, GQA_GROUP, HEAD_DIM),
                     band_blocks(k), band_blocks(v), key_valid, attn_sinks).reshape(n, p, N_HEADS, HEAD_DIM)

    c = jnp.where(valid[None, :, None], c, jnp.zeros_like(c))
    c_act = jax.nn.silu(causal_conv(jnp.pad(c, ((0, 0), (CONV_W - 1, 0), (0, 0))), w_conv, b_conv))
    qm, km, vmh, logi, logf = mlstm_inputs(c_act, vm, i_pre, f_pre, w_mq, w_mk, b_i, b_f)
    logi = jnp.where(valid, logi, -jnp.inf)
    logf = jnp.where(valid, logf, 0.0)

    def chunks(t):
        return jnp.moveaxis(t.reshape(t.shape[:2] + (nb, BLOCK) + t.shape[3:]), 2, 0)

    f32 = jnp.float32
    init = (jnp.zeros((n, M_HEADS, M_HEAD_DIM, M_HEAD_DIM), f32),
            jnp.zeros((n, M_HEADS, M_HEAD_DIM), f32),
            jnp.zeros((n, M_HEADS), f32))

    def step(carry, xs):
        h, new = mlstm_chunk(carry[0], carry[1], carry[2], xs[0], xs[1], xs[2], xs[3], xs[4])
        return new, h

    (C_f, n_f, m_f), hs = lax.scan(step, init, (chunks(qm), chunks(km), chunks(vmh), chunks(logi), chunks(logf)))
    h_m = jnp.moveaxis(hs, 0, 2).reshape(n, M_HEADS, p, M_HEAD_DIM).transpose(0, 2, 1, 3).astype(x.dtype)
    y = mix_and_ffn(x, att, h_m, o_pre, g_attn, g_mlstm, w_out, ln1_g, ln1_b, w_gate, w_up, w_down, ln2_g, ln2_b)
    return y, (k[:, -WINDOW:], v[:, -WINDOW:], c[:, -(CONV_W - 1):], C_f, n_f, m_f)


def sample_layer(x, cache_k, cache_v, state_conv, state_C, state_n, state_m, w_in, w_conv, b_conv, w_mq, w_mk,
                 b_i, b_f, attn_sinks, g_attn, g_mlstm, w_out, ln1_g, ln1_b, w_gate, w_up, w_down, ln2_g, ln2_b):
    n, l, _ = x.shape
    q, k, v, c, vm, o_pre, i_pre, f_pre = split_proj(x, w_in)
    k_all = jnp.concatenate([cache_k, k.reshape(n, l, N_KV_HEADS, HEAD_DIM)], axis=1)
    v_all = jnp.concatenate([cache_v, v.reshape(n, l, N_KV_HEADS, HEAD_DIM)], axis=1)
    key_valid = jnp.ones((1, WINDOW + l), bool)
    att = swa_attend(q.reshape(n, 1, l, N_KV_HEADS, GQA_GROUP, HEAD_DIM), k_all[:, None], v_all[:, None],
                     key_valid, attn_sinks).reshape(n, l, N_HEADS, HEAD_DIM)

    ext = jnp.concatenate([state_conv, c], axis=1)
    c_act = jax.nn.silu(causal_conv(ext, w_conv, b_conv))
    qm, km, vmh, logi, logf = mlstm_inputs(c_act, vm, i_pre, f_pre, w_mq, w_mk, b_i, b_f)
    h, (C_f, n_f, m_f) = mlstm_chunk(state_C, state_n, state_m, qm, km, vmh, logi, logf)
    h_m = h.transpose(0, 2, 1, 3).astype(x.dtype)
    y = mix_and_ffn(x, att, h_m, o_pre, g_attn, g_mlstm, w_out, ln1_g, ln1_b, w_gate, w_up, w_down, ln2_g, ln2_b)
    return y, (k_all[:, -WINDOW:], v_all[:, -WINDOW:], ext[:, -(CONV_W - 1):], C_f, n_f, m_f)


def setup_inputs(seed: int = 0) -> dict:
    key = jax.random.key(seed)
    ks = jax.random.split(key, 32)
    f32 = jnp.float32

    def nrm(k, shape, scale):
        return jax.random.normal(k, shape, f32) * scale

    return {
        'x_prompt': nrm(ks[0], (BATCH, SEQ, D_MODEL), 1.0),
        'x_sample': nrm(ks[1], (DEC_BATCH, DEC_SEQ, D_MODEL), 1.0),
        'cache_k': nrm(ks[2], (DEPTH, DEC_BATCH, WINDOW, N_KV_HEADS, HEAD_DIM), 1.0),
        'cache_v': nrm(ks[3], (DEPTH, DEC_BATCH, WINDOW, N_KV_HEADS, HEAD_DIM), 1.0),
        'state_conv': nrm(ks[4], (DEPTH, DEC_BATCH, CONV_W - 1, MLSTM_W), 1.0),
        'state_C': nrm(ks[5], (DEPTH, DEC_BATCH, M_HEADS, M_HEAD_DIM, M_HEAD_DIM), 0.1),
        'state_n': nrm(ks[6], (DEPTH, DEC_BATCH, M_HEADS, M_HEAD_DIM), 0.1),
        'state_m': nrm(ks[7], (DEPTH, DEC_BATCH, M_HEADS), 1.0),
        'meta_tokens': nrm(ks[8], (N_META, D_MODEL), 1.0),
        'w_in': nrm(ks[9], (DEPTH, D_MODEL, IN_W), D_MODEL ** -0.5),
        'w_conv': nrm(ks[10], (DEPTH, CONV_W, MLSTM_W), CONV_W ** -0.5),
        'b_conv': nrm(ks[11], (DEPTH, MLSTM_W), 0.02),
        'w_mq': nrm(ks[12], (DEPTH, M_HEADS, M_HEAD_DIM, M_HEAD_DIM), M_HEAD_DIM ** -0.5),
        'w_mk': nrm(ks[13], (DEPTH, M_HEADS, M_HEAD_DIM, M_HEAD_DIM), M_HEAD_DIM ** -0.5),
        'b_i': nrm(ks[14], (DEPTH, M_HEADS), 0.1),
        'b_f': jnp.broadcast_to(jnp.linspace(3.0, 6.0, M_HEADS, dtype=f32), (DEPTH, M_HEADS)) + nrm(ks[15], (DEPTH, M_HEADS), 0.01),
        'attn_sinks': nrm(ks[16], (DEPTH, N_HEADS), 0.5),
        'g_attn': 1.0 + nrm(ks[17], (DEPTH, ATT_W), 0.02),
        'g_mlstm': 1.0 + nrm(ks[18], (DEPTH, MLSTM_W), 0.02),
        'w_out': nrm(ks[19], (DEPTH, MIX_W, D_MODEL), MIX_W ** -0.5 * DEEPNORM_BETA),
        'ln1_g': 1.0 + nrm(ks[20], (DEPTH, D_MODEL), 0.02),
        'ln1_b': nrm(ks[21], (DEPTH, D_MODEL), 0.02),
        'w_gate': nrm(ks[22], (DEPTH, D_MODEL, D_FF), D_MODEL ** -0.5),
        'w_up': nrm(ks[23], (DEPTH, D_MODEL, D_FF), D_MODEL ** -0.5),
        'w_down': nrm(ks[24], (DEPTH, D_FF, D_MODEL), D_FF ** -0.5 * DEEPNORM_BETA),
        'ln2_g': 1.0 + nrm(ks[25], (DEPTH, D_MODEL), 0.02),
        'ln2_b': nrm(ks[26], (DEPTH, D_MODEL), 0.02),
    }


def reference(x_prompt, x_sample, cache_k, cache_v, state_conv, state_C, state_n, state_m, meta_tokens,
              w_in, w_conv, b_conv, w_mq, w_mk, b_i, b_f, attn_sinks, g_attn, g_mlstm, w_out,
              ln1_g, ln1_b, w_gate, w_up, w_down, ln2_g, ln2_b):
    b, s, d = x_prompt.shape
    p = s + BLOCK
    meta = jnp.broadcast_to(meta_tokens[None].astype(x_prompt.dtype), (b, N_META, d))
    xp = jnp.concatenate([jnp.zeros((b, META_PAD, d), x_prompt.dtype), meta, x_prompt], axis=1)
    valid = jnp.arange(p) >= META_PAD
    nb = p // BLOCK
    key_pos = (jnp.arange(nb)[:, None] - 1) * BLOCK + jnp.arange(2 * BLOCK)[None, :]
    key_valid = key_pos >= META_PAD
    xs = x_sample
    p_states, s_states = [], []
    for layer in range(DEPTH):
        lw = (w_in[layer], w_conv[layer], b_conv[layer], w_mq[layer], w_mk[layer], b_i[layer], b_f[layer],
              attn_sinks[layer], g_attn[layer], g_mlstm[layer], w_out[layer], ln1_g[layer], ln1_b[layer],
              w_gate[layer], w_up[layer], w_down[layer], ln2_g[layer], ln2_b[layer])
        xp, ps = prompt_layer(xp, valid, key_valid, *lw)
        xs, ss = sample_layer(xs, cache_k[layer], cache_v[layer], state_conv[layer], state_C[layer],
                              state_n[layer], state_m[layer], *lw)
        p_states.append(ps)
        s_states.append(ss)
    pk, pv, pconv, pC, pn, pm = [jnp.stack(t) for t in zip(*p_states)]
    sk, sv, sconv, sC, sn, sm = [jnp.stack(t) for t in zip(*s_states)]
    y_prompt = xp[:, BLOCK:]
    return (y_prompt, xs, pk, pv, pconv, pC, pn, pm, sk, sv, sconv, sC, sn, sm)
```

```cpp
#include <hip/hip_runtime.h>
#include <hip/hip_cooperative_groups.h>
#include <cstdio>
#include <cstdint>
namespace cg = cooperative_groups;
namespace pg8 {
#define PG8_LAS __attribute__((address_space(3)))
typedef unsigned short bf16_t;
typedef short bf16x8 __attribute__((ext_vector_type(8)));
typedef float f32x4 __attribute__((ext_vector_type(4)));
typedef unsigned u32x4 __attribute__((ext_vector_type(4)));
constexpr int BM = 256, BK = 64, HALF = 128, HTB = HALF * BK * 2  , STAGE_BYTES = 8 * HTB, NXCD = 8, WGM = 8;

__host__ __device__ __forceinline__ int lds_byte(int r, int c) { const int st = (r >> 4) * 2 + (c >> 5), rr = r & 15, cc = c & 31, ob = rr * 64 + cc * 2; return st * 1024 + (ob ^ (((ob >> 9) & 1) << 5)); }
__host__ __device__ __forceinline__ void stage_rc(int b, int& R, int& C) { const int st = b / 1024, sb = b % 1024, swz = sb ^ (((sb >> 9) & 1) << 5); R = (st >> 1) * 16 + swz / 64; C = (st & 1) * 32 + (swz % 64) / 2; }
__host__ __device__ __forceinline__ int perm32(int rho) { const int n = rho >> 4, i = rho & 15; return 8 * (i >> 2) + 4 * n + (i & 3); }

struct Unit { int pm, pn, koff, nt; };
struct Gemm { const bf16_t* A; const bf16_t* Bt; int M, N, K; };

struct StaticOrder {
    int nM, nN, nwg, G, c, ntf;
    __host__ __device__ void init(int M, int N, int G_, int c_, int K_ = 1024) { nM = M / BM; nN = N / BM; nwg = nM * nN; G = G_; c = c_; ntf = K_ / BK; }
    __host__ __device__ bool next(int i, Unit& u) const {
        const long L = (long)i * G + c; if (L >= nwg) return false;
        map((int)L, u); return true;
    }
    __host__ __device__ void map(int wgid, Unit& u) const {
        { const int q = nwg / NXCD, r = nwg % NXCD, xcd = wgid % NXCD, off = wgid / NXCD; wgid = (xcd < r ? xcd * (q + 1) : r * (q + 1) + (xcd - r) * q) + off; }
        const int nig = WGM * nN, gid = wgid / nig, fm = gid * WGM, gsz = (nM - fm) < WGM ? (nM - fm) : WGM;
        u.pm = fm + ((wgid % nig) % gsz); u.pn = (wgid % nig) / gsz; u.koff = 0; u.nt = ntf;
    }
    __device__ __forceinline__ void a_ready(const Unit&) const {}
    __device__ __forceinline__ void done(const Unit&) const {}
};

__device__ __forceinline__ unsigned cvt_pk_bf16(float lo, float hi) { unsigned r; asm volatile("v_cvt_pk_bf16_f32 %0, %1, %2" : "=v"(r) : "v"(lo), "v"(hi)); return r; }
typedef float f32x2 __attribute__((ext_vector_type(2)));
template <int S> struct TailOrder {
    StaticOrder so; int ntf;
    __host__ __device__ void init(int N, int G_, int c_, int K_) { so.init(16384, N, G_, c_, K_); ntf = K_ / BK; }
    __host__ __device__ bool next(int i, Unit& u) const {
        const long L = (long)i * so.G + so.c;
        if (L >= so.nwg + 16 * S) return false;
        const bool tail = L >= so.nwg;
        Unit a; so.map(tail ? 0 : (int)L, a);
        const int q = tail ? (int)(L - so.nwg) : 0, tile = q / S, sp = q - tile * S;
        u.pm = tail ? 64 + (tile >> 2) : a.pm; u.pn = tail ? (tile & 3) : a.pn; u.nt = tail ? ntf / S : ntf; u.koff = tail ? sp * (ntf / S) * BK : 0; return true;
    }
    __device__ __forceinline__ void a_ready(const Unit&) const {}
    __device__ __forceinline__ void done(const Unit&) const {}
};
struct EpiStoreBf16 {
    static constexpr bool PERM = true, AFTER_DRAIN = false;
    bf16_t* O; int ldc;
    __device__ __forceinline__ void operator()(const f32x4 (&acc)[2][2][4][2], const Unit& u, int wr, int wc, int fr, int fq) const {
        const int row0 = u.pm * BM + wr * 64 + fr, col0 = u.pn * BM + wc * 32 + 8 * fq;
#pragma unroll
        for (int ai = 0; ai < 2; ++ai)
#pragma unroll
            for (int m = 0; m < 4; ++m) { bf16_t* rowp = O + (size_t)(row0 + ai * HALF + m * 16) * ldc + col0;
#pragma unroll
                for (int bj = 0; bj < 2; ++bj) { const f32x4 v0 = acc[ai][bj][m][0], v1 = acc[ai][bj][m][1];
                    u32x4 w; w.x = cvt_pk_bf16(v0[0], v0[1]); w.y = cvt_pk_bf16(v0[2], v0[3]); w.z = cvt_pk_bf16(v1[0], v1[1]); w.w = cvt_pk_bf16(v1[2], v1[3]);
                    *(u32x4*)(rowp + bj * HALF) = w; } }
    }
};
__device__ __forceinline__ float silu_f(float g) { return g * __builtin_amdgcn_rcpf(1.0f + __expf(-g)); }
struct EpiSwiGLU {
    static constexpr bool PERM = true, AFTER_DRAIN = false;
    bf16_t* H; int ldh;
    __device__ __forceinline__ void operator()(const f32x4 (&acc)[2][2][4][2], const Unit& u, int wr, int wc, int fr, int fq) const {
        const int row0 = u.pm * BM + wr * 64 + fr, col0 = u.pn * HALF + wc * 32 + 8 * fq;
#pragma unroll
        for (int ai = 0; ai < 2; ++ai)
#pragma unroll
            for (int m = 0; m < 4; ++m) { bf16_t* rowp = H + (size_t)(row0 + ai * HALF + m * 16) * ldh + col0;
                const f32x4 g0 = acc[ai][0][m][0], g1 = acc[ai][0][m][1], u0 = acc[ai][1][m][0], u1 = acc[ai][1][m][1];
                u32x4 w; w.x = cvt_pk_bf16(silu_f(g0[0]) * u0[0], silu_f(g0[1]) * u0[1]); w.y = cvt_pk_bf16(silu_f(g0[2]) * u0[2], silu_f(g0[3]) * u0[3]);
                w.z = cvt_pk_bf16(silu_f(g1[0]) * u1[0], silu_f(g1[1]) * u1[1]); w.w = cvt_pk_bf16(silu_f(g1[2]) * u1[2], silu_f(g1[3]) * u1[3]);
                *(u32x4*)rowp = w; }
    }
};
template <bool BASE_BF16, int NS0, int KPER, long OFF0, long OFF1>
struct EpiResSlab {
    static constexpr bool PERM = false, AFTER_DRAIN = false;
    const void* base; bf16_t* out; float* wsf;
    __device__ __forceinline__ void operator()(const f32x4 (&acc)[2][2][4][2], const Unit& u, int wr, int wc, int fr, int fq) const {
        typedef unsigned u32x2v __attribute__((ext_vector_type(2)));
        constexpr int ld = 1024; constexpr float alpha = 1.189207115002721f;
        const int col0 = u.pn * BM + wc * 32 + 4 * fq;
        if (u.pm < 64) {
            const size_t t0 = (size_t)(u.pm * BM) * ld;
            f32x4 t[2][2][4][2];
#pragma unroll
            for (int ai = 0; ai < 2; ++ai)
#pragma unroll
                for (int m = 0; m < 4; ++m) { const int r = ai * HALF + wr * 64 + m * 16 + fr;
#pragma unroll
                    for (int bj = 0; bj < 2; ++bj)
#pragma unroll
                        for (int n = 0; n < 2; ++n) { const size_t o = t0 + (size_t)r * ld + col0 + bj * HALF + n * 16; f32x4 bv;
                            if (BASE_BF16) { const u32x2v w = *(const u32x2v*)((const bf16_t*)base + o); bv = (f32x4){__uint_as_float(w.x << 16), __uint_as_float(w.x & 0xffff0000u), __uint_as_float(w.y << 16), __uint_as_float(w.y & 0xffff0000u)}; }
                            else bv = *(const f32x4*)((const float*)base + o);
                            t[ai][bj][m][n] = bv * alpha + acc[ai][bj][m][n]; } }
            asm volatile("s_waitcnt vmcnt(0)" ::: "memory");
#pragma unroll
            for (int ai = 0; ai < 2; ++ai)
#pragma unroll
                for (int m = 0; m < 4; ++m) { const int r = ai * HALF + wr * 64 + m * 16 + fr;
#pragma unroll
                    for (int bj = 0; bj < 2; ++bj)
#pragma unroll
                        for (int n = 0; n < 2; ++n) { const size_t o = t0 + (size_t)r * ld + col0 + bj * HALF + n * 16;
                            u32x2v ow; ow.x = cvt_pk_bf16(t[ai][bj][m][n][0], t[ai][bj][m][n][1]); ow.y = cvt_pk_bf16(t[ai][bj][m][n][2], t[ai][bj][m][n][3]); *(u32x2v*)(out + o) = ow; } }
        } else {
            const int sp = u.koff / KPER;
            float* ot = wsf + (sp < NS0 ? OFF0 + (long)sp * 1048576 : OFF1 + (long)(sp - NS0) * 1048576) + (long)((u.pm - 64) * BM) * ld;
#pragma unroll
            for (int ai = 0; ai < 2; ++ai)
#pragma unroll
                for (int m = 0; m < 4; ++m) { const int r = ai * HALF + wr * 64 + m * 16 + fr;
#pragma unroll
                    for (int bj = 0; bj < 2; ++bj)
#pragma unroll
                        for (int n = 0; n < 2; ++n) *(f32x4*)(ot + (size_t)r * ld + col0 + bj * HALF + n * 16) = acc[ai][bj][m][n]; }
        }
    }
};
template <class Epi, class Sched, bool ALIGN_EPI = false, bool SP2 = false, bool VARK = false>
__device__ __forceinline__ void gemm_phase(PG8_LAS unsigned char* lds, const Gemm g, const Sched S, const Epi E) {
    int tid_ = threadIdx.x; asm volatile("" : "+v"(tid_));
    const int tid = tid_, wid = __builtin_amdgcn_readfirstlane(tid >> 6), lane = tid & 63, wr = wid >> 2, wc = wid & 3, fr = lane & 15, fq = lane >> 4;
    const int K = g.K;
    unsigned voffA[2], voffB[2];
#pragma unroll
    for (int i = 0; i < 2; ++i) { int R, C; stage_rc(tid * 16 + i * 8192, R, C); const int Rb = Epi::PERM ? ((R & ~31) + perm32(R & 31)) : R;
        voffA[i] = (unsigned)(R * K + C) * 2u; voffB[i] = (unsigned)(Rb * K + C) * 2u; }
    const size_t kstep = (size_t)(BK * 2);
    const size_t hstep = (size_t)HALF * K * 2;
    const size_t tstep = 2 * hstep;
    const unsigned ldsw = (unsigned)wid * 1024u;
    const int aoff = lds_byte(wr * 64 + fr, fq * 8), boff = lds_byte(wc * 32 + fr, fq * 8);
#define PG8_SA(b, h) (((b) * 2 + (h)) * HTB)
#define PG8_SB(b, h) ((4 + (b) * 2 + (h)) * HTB)
#define PG8_STAGE(bufoff, gbase, voff) do { _Pragma("unroll") for (int _i = 0; _i < 2; ++_i) \
        __builtin_amdgcn_global_load_lds((const unsigned*)((const char*)(gbase) + (voff)[_i]), (PG8_LAS unsigned*)(lds + (bufoff) + ldsw + _i * 8192), 16, 0, 0); } while (0)
#define PG8_LDA(dst, b, h) do { _Pragma("unroll") for (int m = 0; m < 4; ++m) _Pragma("unroll") for (int k = 0; k < 2; ++k) dst[m][k] = *(const PG8_LAS bf16x8*)(lds + PG8_SA(b, h) + aoff + m * 2048 + k * 1024); } while (0)
#define PG8_LDB(dst, b, h) do { _Pragma("unroll") for (int n = 0; n < 2; ++n) _Pragma("unroll") for (int k = 0; k < 2; ++k) dst[n][k] = *(const PG8_LAS bf16x8*)(lds + PG8_SB(b, h) + boff + n * 2048 + k * 1024); } while (0)
#define PG8_MMA(ai, bj, At, Bt) do { __builtin_amdgcn_s_setprio(1); _Pragma("unroll") for (int m = 0; m < 4; ++m) _Pragma("unroll") for (int n = 0; n < 2; ++n) _Pragma("unroll") for (int k = 0; k < 2; ++k) \
        acc[ai][bj][m][n] = __builtin_amdgcn_mfma_f32_16x16x32_bf16(Bt[n][k], At[m][k], acc[ai][bj][m][n], 0, 0, 0); __builtin_amdgcn_s_setprio(0); } while (0)
#define PG8_WAIT_V(n) asm volatile("s_waitcnt vmcnt(" #n ")" ::: "memory")
#define PG8_WAIT_L(n) asm volatile("s_waitcnt lgkmcnt(" #n ")" ::: "memory")
#define PG8_BAR __builtin_amdgcn_s_barrier()
#define PG8_SCHED __builtin_amdgcn_sched_barrier(0)
    Unit cur, nxt; int ui = 0;
    if (!S.next(0, cur)) return;
    f32x4 acc[2][2][4][2];
#pragma unroll
    for (int a = 0; a < 2; ++a)
#pragma unroll
        for (int b = 0; b < 2; ++b)
#pragma unroll
            for (int m = 0; m < 4; ++m)
#pragma unroll
                for (int n = 0; n < 2; ++n) acc[a][b][m][n] = (f32x4){0.f, 0.f, 0.f, 0.f};
    bf16x8 At[4][2], B0[2][2], B1[2][2];
    const char* cA = (const char*)g.A + (size_t)cur.pm * tstep + (VARK ? (size_t)cur.koff * 2 : 0); const char* cB = (const char*)g.Bt + (size_t)cur.pn * tstep + (VARK ? (size_t)cur.koff * 2 : 0);
    S.a_ready(cur);
    if constexpr (SP2) {
        PG8_STAGE(PG8_SB(0, 0), cB, voffB); PG8_STAGE(PG8_SB(0, 1), cB + hstep, voffB); PG8_STAGE(PG8_SA(0, 0), cA, voffA); PG8_STAGE(PG8_SA(0, 1), cA + hstep, voffA);
        if (wr == 1) PG8_BAR;
        PG8_WAIT_V(2); PG8_BAR;
        PG8_STAGE(PG8_SB(1, 0), cB + kstep, voffB); PG8_STAGE(PG8_SA(1, 0), cA + kstep, voffA); PG8_STAGE(PG8_SB(1, 1), cB + hstep + kstep, voffB);
        PG8_WAIT_V(6); PG8_BAR;
    } else {
        PG8_STAGE(PG8_SB(0, 0), cB, voffB); PG8_STAGE(PG8_SA(0, 0), cA, voffA); PG8_STAGE(PG8_SB(0, 1), cB + hstep, voffB); PG8_STAGE(PG8_SA(0, 1), cA + hstep, voffA);
        if (wr == 1) PG8_BAR;
        PG8_WAIT_V(4); PG8_BAR;
        PG8_STAGE(PG8_SB(1, 0), cB + kstep, voffB); PG8_STAGE(PG8_SA(1, 0), cA + kstep, voffA); PG8_STAGE(PG8_SB(1, 1), cB + hstep + kstep, voffB);
        PG8_WAIT_V(6); PG8_BAR;
    }
    for (;;) {
        const bool has_next = S.next(ui + 1, nxt);
        const char* nA = has_next ? (const char*)g.A + (size_t)nxt.pm * tstep + (VARK ? (size_t)nxt.koff * 2 : 0) : cA; const char* nB = has_next ? (const char*)g.Bt + (size_t)nxt.pn * tstep + (VARK ? (size_t)nxt.koff * 2 : 0) : cB;
        const int nt = VARK ? cur.nt : K / BK;
        for (int t = 0; t < nt; t += 2) {
            const bool last = (t == nt - 2);
            const char* a1 = cA + (size_t)(t + 1) * kstep;
            const char* a2 = last ? nA : cA + (size_t)(t + 2) * kstep; const char* b2 = last ? nB : cB + (size_t)(t + 2) * kstep;
            const char* a3 = a2 + kstep; const char* b3 = b2 + kstep;
            if (last && has_next) S.a_ready(nxt);
            if constexpr (SP2) {
            PG8_LDB(B0, 0, 0); PG8_LDB(B1, 0, 1); PG8_SCHED; PG8_LDA(At, 0, 0); PG8_STAGE(PG8_SA(1, 1), a1 + hstep, voffA);
            PG8_WAIT_V(8); PG8_WAIT_L(0); PG8_BAR; PG8_MMA(0, 0, At, B0); PG8_MMA(0, 1, At, B1); PG8_BAR; PG8_SCHED;
            PG8_LDA(At, 0, 1); PG8_STAGE(PG8_SB(0, 0), b2, voffB); PG8_STAGE(PG8_SB(0, 1), b2 + hstep, voffB); PG8_STAGE(PG8_SA(0, 0), a2, voffA);
            PG8_WAIT_V(8); PG8_WAIT_L(0); PG8_BAR; PG8_MMA(1, 0, At, B0); PG8_MMA(1, 1, At, B1); PG8_BAR; PG8_SCHED;
            PG8_LDB(B0, 1, 0); PG8_LDB(B1, 1, 1); PG8_SCHED; PG8_LDA(At, 1, 0); PG8_STAGE(PG8_SA(0, 1), a2 + hstep, voffA);
            PG8_WAIT_V(8); PG8_WAIT_L(0); PG8_BAR; PG8_MMA(0, 0, At, B0); PG8_MMA(0, 1, At, B1); PG8_BAR; PG8_SCHED;
            PG8_LDA(At, 1, 1); PG8_STAGE(PG8_SB(1, 0), b3, voffB); PG8_STAGE(PG8_SB(1, 1), b3 + hstep, voffB); PG8_STAGE(PG8_SA(1, 0), a3, voffA);
            PG8_WAIT_V(8); PG8_WAIT_L(0); PG8_BAR; PG8_MMA(1, 0, At, B0); PG8_MMA(1, 1, At, B1); PG8_BAR; PG8_SCHED;
            } else {
            PG8_LDB(B0, 0, 0); PG8_SCHED; PG8_LDA(At, 0, 0); PG8_STAGE(PG8_SA(1, 1), a1 + hstep, voffA);
            PG8_WAIT_L(8); PG8_BAR; PG8_WAIT_L(0); PG8_MMA(0, 0, At, B0); PG8_BAR; PG8_SCHED;
            PG8_LDB(B1, 0, 1); PG8_STAGE(PG8_SB(0, 0), b2, voffB);
            PG8_BAR; PG8_WAIT_L(0); PG8_MMA(0, 1, At, B1); PG8_BAR;
            PG8_LDA(At, 0, 1); PG8_STAGE(PG8_SA(0, 0), a2, voffA);
            PG8_BAR; PG8_WAIT_L(0); PG8_MMA(1, 0, At, B0); PG8_BAR; PG8_SCHED;
            PG8_STAGE(PG8_SB(0, 1), b2 + hstep, voffB);
            PG8_WAIT_V(6); PG8_BAR; PG8_MMA(1, 1, At, B1); PG8_BAR;
            PG8_LDB(B0, 1, 0); PG8_SCHED; PG8_LDA(At, 1, 0); PG8_STAGE(PG8_SA(0, 1), a2 + hstep, voffA);
            PG8_WAIT_L(8); PG8_BAR; PG8_WAIT_L(0); PG8_MMA(0, 0, At, B0); PG8_BAR; PG8_SCHED;
            PG8_LDB(B1, 1, 1); PG8_STAGE(PG8_SB(1, 0), b3, voffB);
            PG8_BAR; PG8_WAIT_L(0); PG8_MMA(0, 1, At, B1); PG8_BAR;
            PG8_LDA(At, 1, 1); PG8_STAGE(PG8_SA(1, 0), a3, voffA);
            PG8_BAR; PG8_WAIT_L(0); PG8_MMA(1, 0, At, B0); PG8_BAR; PG8_SCHED;
            PG8_STAGE(PG8_SB(1, 1), b3 + hstep, voffB);
            PG8_WAIT_V(6); PG8_BAR; PG8_MMA(1, 1, At, B1); PG8_BAR;
            }
        }
        if constexpr (ALIGN_EPI) { if (wr == 0) PG8_BAR; }
        if constexpr (!Epi::AFTER_DRAIN) { E(acc, cur, wr, wc, fr, fq); S.done(cur); }
        if (!has_next) break;
#pragma unroll
        for (int a = 0; a < 2; ++a)
#pragma unroll
            for (int b = 0; b < 2; ++b)
#pragma unroll
                for (int m = 0; m < 4; ++m)
#pragma unroll
                    for (int n = 0; n < 2; ++n) acc[a][b][m][n] = (f32x4){0.f, 0.f, 0.f, 0.f};
        cur = nxt; cA = nA; cB = nB; ++ui;
        if constexpr (ALIGN_EPI) { if (wr == 1) PG8_BAR; }
    }
    PG8_WAIT_V(0);
    if constexpr (!ALIGN_EPI) { if (wr == 0) PG8_BAR; }
    PG8_BAR;
    if constexpr (Epi::AFTER_DRAIN) { E.fused(acc, cur, wr, wc, fr, fq, lds, wid, lane); S.done(cur); }
#undef PG8_SA
#undef PG8_SB
#undef PG8_STAGE
#undef PG8_LDA
#undef PG8_LDB
#undef PG8_MMA
#undef PG8_WAIT_V
#undef PG8_WAIT_L
#undef PG8_BAR
#undef PG8_SCHED
}
}

#define LAS __attribute__((address_space(3)))
typedef unsigned short bf16;
typedef unsigned v4u __attribute__((ext_vector_type(4)));
typedef unsigned v2u __attribute__((ext_vector_type(2)));
typedef float f32x4 __attribute__((ext_vector_type(4)));
typedef float f32x2 __attribute__((ext_vector_type(2)));
typedef short bf16x8 __attribute__((ext_vector_type(8)));
#define MFMA16(a, b, c) __builtin_amdgcn_mfma_f32_16x16x32_bf16((a), (b), (c), 0, 0, 0)
#define LDS_WAIT() asm volatile("s_waitcnt lgkmcnt(0)" ::: "memory")

constexpr int NTHR = 512;
constexpr int MROWS = 17920, MMAIN = 17408, R_SAMPLE = 16384, R_BLK0 = 17408;
constexpr int ZW = 2304, INW = 2312, DFF = 2816;
constexpr int ZC_K = 512, ZC_V = 640, ZC_C = 768, ZC_VM = 1280, ZC_O = 1792;
constexpr float ALPHA = 1.189207115002721f, LN_EPS = 1e-5f, KSCALE = 0.08838834764831845f;
enum { I_XP = 0, I_XS, I_CK, I_CV, I_SCONV, I_SC, I_SN, I_SM, I_META, I_WIN, I_WCONV, I_BCONV, I_WMQ, I_WMK, I_BI, I_BF, I_SINK, I_GATT, I_GML, I_WOUT, I_LN1G, I_LN1B, I_WGATE, I_WUP, I_WDOWN, I_LN2G, I_LN2B };
constexpr size_t O_YP = 0, O_YS = 16777216, O_PK = O_YS + 1048576, O_PV = O_PK + 65536, O_PCONV = O_PV + 65536, O_PC = O_PCONV + 6144, O_PN = O_PC + 262144, O_PM = O_PN + 2048,
                 O_SK = O_PM + 16, O_SV = O_SK + 2097152, O_SCONV = O_SV + 2097152, O_SC = O_SCONV + 196608, O_SN = O_SC + 8388608, O_SM = O_SN + 65536, O_END = O_SM + 512;
static_assert(O_END == 31072784, "output size");
constexpr size_t MiB = 1u << 20;
constexpr size_t WS_WIN = 1 * MiB, WS_WOUT = 6 * MiB, WS_WGU = 8 * MiB, WS_WDN = 19 * MiB, WS_WMQ = 25 * MiB, WS_WMK = 25 * MiB + 131072;
constexpr size_t WS_GATES = 26 * MiB, WS_SCAL = 27 * MiB, WS_CSUM = 27 * MiB + 32768, WS_DN = 27 * MiB + 65536, WS_NS = 27 * MiB + 524288;
constexpr size_t WS_XB = 29 * MiB, WS_DC = 29 * MiB, WS_Z = 64 * MiB, WS_QM = 143 * MiB, WS_KM = 143 * MiB + (size_t)MROWS * 512 * 2, WS_CS = 178 * MiB, WS_Y = 195 * MiB;
constexpr size_t WS_T1 = 29 * MiB, WS_X1B = 97 * MiB, WS_H = 131 * MiB, WS_X1S = 229 * MiB  , WS_SLABB = 233 * MiB  , WS_SLABA = 29 * MiB  , WS_T2B = 61 * MiB  , WS_TOKG = 249 * MiB  , WS_END = 251 * MiB;
static_assert(WS_KM + (size_t)MROWS * 512 * 2 <= WS_CS && WS_Z + (size_t)MROWS * ZW * 2 <= WS_QM && WS_H + (size_t)MMAIN * DFF * 2 <= WS_END && WS_T1 + (size_t)MMAIN * 4096 <= WS_X1B, "ws map");
constexpr int LDS_BYTES = 132096;

struct Params { const float* in[27]; float* out; unsigned char* ws; int ph_lo, ph_hi; };

__device__ __forceinline__ int row_of(int b, int pos) { return pos >= 128 ? b * 4096 + (pos - 128) : R_BLK0 + b * 128 + pos; }
__device__ __forceinline__ float bflo(unsigned w) { return __uint_as_float(w << 16); }
__device__ __forceinline__ float bfhi(unsigned w) { return __uint_as_float(w & 0xffff0000u); }
__device__ __forceinline__ float bf2f(unsigned short h) { return __uint_as_float(((unsigned)h) << 16); }
__device__ __forceinline__ unsigned pk2(float lo, float hi) { return pg8::cvt_pk_bf16(lo, hi); }
__device__ __forceinline__ unsigned short f2bf1(float x) { return (unsigned short)(pg8::cvt_pk_bf16(x, 0.f) & 0xffffu); }
__device__ __forceinline__ float wave_sum(float v) {
#pragma unroll
    for (int o = 1; o < 64; o <<= 1) v += __shfl_xor(v, o);
    return v;
}
__device__ __forceinline__ float quad_sum(float v) { v += __shfl_xor(v, 16); v += __shfl_xor(v, 32); return v; }
__device__ __forceinline__ float quad_max(float v) { v = fmaxf(v, __shfl_xor(v, 16)); v = fmaxf(v, __shfl_xor(v, 32)); return v; }
__device__ __forceinline__ float sigmoid_f(float x) { return 1.0f / (1.0f + __expf(-x)); }
__device__ __forceinline__ float logsig_f(float x) { return fminf(x, 0.f) - __logf(1.0f + __expf(-fabsf(x))); }
__device__ __forceinline__ void unpack8(const v4u r, float (&x)[8]) { x[0] = bflo(r.x); x[1] = bfhi(r.x); x[2] = bflo(r.y); x[3] = bfhi(r.y); x[4] = bflo(r.z); x[5] = bfhi(r.z); x[6] = bflo(r.w); x[7] = bfhi(r.w); }
__device__ __forceinline__ unsigned elem16(const v4u r, int e) { const unsigned w = (e >> 1) == 0 ? r.x : (e >> 1) == 1 ? r.y : (e >> 1) == 2 ? r.z : r.w; return (e & 1) ? (w >> 16) : (w & 0xffffu); }
__device__ __forceinline__ void store_vt(LAS bf16* VT, int stride, int c0, int s0, const v4u (&raw)[4]) {
#pragma unroll
    for (int e = 0; e < 8; ++e) { v2u o; o.x = elem16(raw[0], e) | (elem16(raw[1], e) << 16); o.y = elem16(raw[2], e) | (elem16(raw[3], e) << 16);
        *(LAS v2u*)(VT + (c0 + e) * stride + s0) = o; }
}
__device__ __forceinline__ bf16x8 mk8(const v2u lo, const v2u hi) { v4u t; t.x = lo.x; t.y = lo.y; t.z = hi.x; t.w = hi.y; return __builtin_bit_cast(bf16x8, t); }
__device__ __forceinline__ bf16x8 pack8(const float (&p)[8]) { v4u t; t.x = pk2(p[0], p[1]); t.y = pk2(p[2], p[3]); t.z = pk2(p[4], p[5]); t.w = pk2(p[6], p[7]); return __builtin_bit_cast(bf16x8, t); }

__device__ __forceinline__ void tr_item(const float* W, int ldw, int k0, int n0, bf16* WT, int drow0, int ldk, LAS float* scr, int lane) {
#pragma unroll
    for (int i = 0; i < 8; ++i) { const int kk = 8 * i + (lane >> 3), c4 = lane & 7; const f32x4 v = *(const f32x4*)(W + (size_t)(k0 + kk) * ldw + n0 + 4 * c4);
        LAS float* d = scr + kk * 33 + 4 * c4; d[0] = v[0]; d[1] = v[1]; d[2] = v[2]; d[3] = v[3]; }
    LDS_WAIT();
    const int c = lane & 7;
#pragma unroll
    for (int j = 0; j < 4; ++j) { const int n = (lane >> 3) + 8 * j; const LAS float* s = scr + (8 * c) * 33 + n;
        v4u o; o.x = pk2(s[0 * 33], s[1 * 33]); o.y = pk2(s[2 * 33], s[3 * 33]); o.z = pk2(s[4 * 33], s[5 * 33]); o.w = pk2(s[6 * 33], s[7 * 33]);
        *(v4u*)(WT + (size_t)(drow0 + n) * ldk + k0 + 8 * c) = o; }
    LDS_WAIT();
}
__device__ __forceinline__ void scan_vals(const float (&li)[2], const float (&lf)[2], int lane, float (&bb)[2], float (&aa)[2], float (&mx)[2]) {
    const float s = lf[0] + lf[1]; float sc = s;
#pragma unroll
    for (int o = 1; o < 64; o <<= 1) { const float n = __shfl_up(sc, o); if (lane >= o) sc += n; }
    const float excl = sc - s;
    bb[0] = excl + lf[0]; bb[1] = bb[0] + lf[1];
    aa[0] = li[0] - bb[0]; aa[1] = li[1] - bb[1];
    float pc = fmaxf(aa[0], aa[1]);
#pragma unroll
    for (int o = 1; o < 64; o <<= 1) { const float n = __shfl_up(pc, o); if (lane >= o) pc = fmaxf(pc, n); }
    float exm = __shfl_up(pc, 1); if (lane == 0) exm = -INFINITY;
    mx[0] = fmaxf(exm, aa[0]); mx[1] = fmaxf(mx[0], aa[1]);
}
__device__ __forceinline__ void p0_load_row(const Params& p, int R, int lane, f32x4 (&v)[4]) {
    const float* src = nullptr;
    if (R < R_SAMPLE) src = p.in[I_XP] + (size_t)R * 1024;
    else if (R < R_BLK0) src = p.in[I_XS] + (size_t)(R - R_SAMPLE) * 1024;
    else { const int pp = (R - R_BLK0) & 127; if (pp >= 112) src = p.in[I_META] + (size_t)(pp - 112) * 1024; }
    if (src) {
#pragma unroll
        for (int j = 0; j < 4; ++j) v[j] = ((const f32x4*)src)[lane + 64 * j];
    } else {
#pragma unroll
        for (int j = 0; j < 4; ++j) v[j] = (f32x4){0.f, 0.f, 0.f, 0.f};
    }
}
__device__ __forceinline__ void p0_prologue(const Params& p, LAS unsigned char* lds, int tid) {
    const int lane = tid & 63, wave = __builtin_amdgcn_readfirstlane(tid >> 6);
    LAS float* scr = (LAS float*)(lds + wave * 16384);
    unsigned char* ws = p.ws;
    const int gw = (int)blockIdx.x * 8 + wave, NGW = (int)gridDim.x * 8;
    {
        f32x4 wa[4][4], wb[4][4];
        {
            LAS float* wl = (LAS float*)lds;
            for (int k = tid; k < 1024; k += NTHR) { const float* wp = p.in[I_WIN] + (size_t)k * INW + ZW; *(LAS f32x4*)(wl + k * 8) = *(const f32x4*)wp; *(LAS f32x4*)(wl + k * 8 + 4) = *(const f32x4*)(wp + 4); }
            __syncthreads();
#pragma unroll
            for (int j = 0; j < 4; ++j)
#pragma unroll
                for (int e = 0; e < 4; ++e) { const LAS float* wp = wl + (4 * lane + 256 * j + e) * 8; wa[j][e] = *(const LAS f32x4*)wp; wb[j][e] = *(const LAS f32x4*)(wp + 4); }
            __syncthreads();
        }
        bf16* Xb = (bf16*)(ws + WS_XB); float* gates = (float*)(ws + WS_GATES);
        f32x4 v[4];
        int R = gw; if (R < MROWS) p0_load_row(p, R, lane, v);
        while (R < MROWS) {
            const int Rn = R + NGW; f32x4 vn[4];
            if (Rn < MROWS) p0_load_row(p, Rn, lane, vn);
            f32x4 ga = {0.f, 0.f, 0.f, 0.f}, gb = {0.f, 0.f, 0.f, 0.f};
            unsigned long long* o8 = (unsigned long long*)(Xb + (size_t)R * 1024) + lane;
#pragma unroll
            for (int j = 0; j < 4; ++j) {
                o8[64 * j] = (unsigned long long)pk2(v[j][0], v[j][1]) | ((unsigned long long)pk2(v[j][2], v[j][3]) << 32);
#pragma unroll
                for (int e = 0; e < 4; ++e) { ga += wa[j][e] * v[j][e]; gb += wb[j][e] * v[j][e]; }
            }
#pragma unroll
            for (int e = 0; e < 4; ++e) { ga[e] = wave_sum(ga[e]); gb[e] = wave_sum(gb[e]); }
            if (lane == 0) { *(f32x4*)(gates + (size_t)R * 8) = ga; *(f32x4*)(gates + (size_t)R * 8 + 4) = gb; }
#pragma unroll
            for (int j = 0; j < 4; ++j) v[j] = vn[j];
            R = Rn;
        }
    }
    constexpr int I_IN = 16 * 72, I_OUT = 16 * 32, I_G = 16 * 88, I_D = 44 * 32, I_M = 32;
    constexpr int NIT = I_IN + I_OUT + 2 * I_G + I_D + 2 * I_M;
    for (int it = gw; it < NIT; it += NGW) {
        int r = it;
        if (r < I_IN) { const int kb = r / 72, nb = r % 72; tr_item(p.in[I_WIN], INW, 64 * kb, 32 * nb, (bf16*)(ws + WS_WIN), 32 * nb, 1024, scr, lane); continue; } r -= I_IN;
        if (r < I_OUT) { const int kb = r / 32, nb = r % 32; tr_item(p.in[I_WOUT], 1024, 64 * kb, 32 * nb, (bf16*)(ws + WS_WOUT), 32 * nb, 1024, scr, lane); continue; } r -= I_OUT;
        if (r < I_G) { const int kb = r / 88, nb = r % 88, n0 = 32 * nb; tr_item(p.in[I_WGATE], DFF, 64 * kb, n0, (bf16*)(ws + WS_WGU), (n0 >> 7) * 256 + (n0 & 127), 1024, scr, lane); continue; } r -= I_G;
        if (r < I_G) { const int kb = r / 88, nb = r % 88, n0 = 32 * nb; tr_item(p.in[I_WUP], DFF, 64 * kb, n0, (bf16*)(ws + WS_WGU), (n0 >> 7) * 256 + 128 + (n0 & 127), 1024, scr, lane); continue; } r -= I_G;
        if (r < I_D) { const int kb = r / 32, nb = r % 32; tr_item(p.in[I_WDOWN], 1024, 64 * kb, 32 * nb, (bf16*)(ws + WS_WDN), 32 * nb, DFF, scr, lane); continue; } r -= I_D;
        if (r < I_M) { const int h = r >> 3, kb = (r >> 2) & 1, nb = r & 3; tr_item(p.in[I_WMQ] + h * 16384, 128, 64 * kb, 32 * nb, (bf16*)(ws + WS_WMQ) + h * 16384, 32 * nb, 128, scr, lane); continue; } r -= I_M;
        { const int h = r >> 3, kb = (r >> 2) & 1, nb = r & 3; tr_item(p.in[I_WMK] + h * 16384, 128, 64 * kb, 32 * nb, (bf16*)(ws + WS_WMK) + h * 16384, 32 * nb, 128, scr, lane); }
    }
}

__device__ __forceinline__ void chunk_scan(const float* gates, const float* b_i, const float* b_f, int b, int j, int h, int lane, float (&bb)[2], float (&aa)[2], float (&mx)[2]) {
    const int R0 = row_of(b, 128 * j);
    float li[2], lf[2];
#pragma unroll
    for (int i = 0; i < 2; ++i) { const int t = 2 * lane + i, pos = 128 * j + t; const float* g = gates + (size_t)(R0 + t) * 8;
        const float ip = g[h] + b_i[h], fp = g[4 + h] + b_f[h]; const bool valid = pos >= 112;
        li[i] = valid ? ip : -INFINITY; lf[i] = valid ? logsig_f(fp) : 0.f; }
    scan_vals(li, lf, lane, bb, aa, mx);
}

template <bool SAMPLE>
__device__ __forceinline__ void unit_mlstm_a(const Params& p, LAS unsigned char* lds, int tid, int b, int j, int h) {
    const int lane = tid & 63, wave = __builtin_amdgcn_readfirstlane(tid >> 6);
    LAS bf16* CA = (LAS bf16*)lds; LAS bf16* VT = (LAS bf16*)(lds + 34816); LAS bf16* KT = (LAS bf16*)(lds + 69632);
    LAS float* wk = (LAS float*)(lds + 104448); LAS float* sB = wk + 128; LAS float* sM = sB + 64;
    unsigned char* ws = p.ws;
    const bf16* Z = (const bf16*)(ws + WS_Z); const float* gates = (const float*)(ws + WS_GATES);
    const int u = SAMPLE ? 0 : (b * 33 + j) * 4 + h, R0 = SAMPLE ? R_SAMPLE + 128 * b : row_of(b, 128 * j);
    {
        const int rg = tid >> 4, c8 = tid & 15, col = 128 * h + 8 * c8;
        float wc[4][8], bc[8];
#pragma unroll
        for (int jj = 0; jj < 4; ++jj) { const f32x4 a0 = *(const f32x4*)(p.in[I_WCONV] + jj * 512 + col), a1 = *(const f32x4*)(p.in[I_WCONV] + jj * 512 + col + 4);
            wc[jj][0] = a0[0]; wc[jj][1] = a0[1]; wc[jj][2] = a0[2]; wc[jj][3] = a0[3]; wc[jj][4] = a1[0]; wc[jj][5] = a1[1]; wc[jj][6] = a1[2]; wc[jj][7] = a1[3]; }
        { const f32x4 a0 = *(const f32x4*)(p.in[I_BCONV] + col), a1 = *(const f32x4*)(p.in[I_BCONV] + col + 4);
            bc[0] = a0[0]; bc[1] = a0[1]; bc[2] = a0[2]; bc[3] = a0[3]; bc[4] = a1[0]; bc[5] = a1[1]; bc[6] = a1[2]; bc[7] = a1[3]; }
        float x[7][8];
#pragma unroll
        for (int i = 0; i < 7; ++i) { const int lt = 4 * rg + i - 3; v4u raw = {0u, 0u, 0u, 0u};
            if (SAMPLE) {
                if (i >= 3 || (rg & 1)) { raw = *(const v4u*)(Z + (size_t)(R0 + lt) * ZW + ZC_C + col); unpack8(raw, x[i]); }
                else { const float* sp = p.in[I_SCONV] + (size_t)((16 * b + (rg >> 1)) * 3 + i) * 512 + col; const f32x4 a0 = *(const f32x4*)sp, a1 = *(const f32x4*)(sp + 4);
                    x[i][0] = a0[0]; x[i][1] = a0[1]; x[i][2] = a0[2]; x[i][3] = a0[3]; x[i][4] = a1[0]; x[i][5] = a1[1]; x[i][6] = a1[2]; x[i][7] = a1[3]; }
            } else {
                if (lt >= 0) raw = *(const v4u*)(Z + (size_t)(R0 + lt) * ZW + ZC_C + col);
                else if (j > 0) raw = *(const v4u*)(Z + (size_t)row_of(b, 128 * j + lt) * ZW + ZC_C + col);
                unpack8(raw, x[i]); } }
#pragma unroll
        for (int r = 0; r < 4; ++r) { float y[8];
#pragma unroll
            for (int e = 0; e < 8; ++e) { const float t = bc[e] + wc[0][e] * x[r][e] + wc[1][e] * x[r + 1][e] + wc[2][e] * x[r + 2][e] + wc[3][e] * x[r + 3][e]; y[e] = t * sigmoid_f(t); }
            v4u o; o.x = pk2(y[0], y[1]); o.y = pk2(y[2], y[3]); o.z = pk2(y[4], y[5]); o.w = pk2(y[6], y[7]);
            *(LAS v4u*)(CA + (4 * rg + r) * 136 + 8 * c8) = o; }
        if (!SAMPLE) { v4u raw[4];
#pragma unroll
            for (int r = 0; r < 4; ++r) raw[r] = *(const v4u*)(Z + (size_t)(R0 + 4 * rg + r) * ZW + ZC_VM + col);
            store_vt(VT, 136, 8 * c8, 4 * rg, raw); }
    }
    if (!SAMPLE && wave == 0) {
        float bb[2], aa[2], mx[2]; chunk_scan(gates, p.in[I_BI], p.in[I_BF], b, j, h, lane, bb, aa, mx);
        const float Bc = __shfl(bb[1], 63), Ml = __shfl(mx[1], 63), Mref = (Ml == -INFINITY) ? 0.f : Ml;
        wk[2 * lane] = __expf(aa[0] - Mref); wk[2 * lane + 1] = __expf(aa[1] - Mref);
        float* tg = (float*)(ws + WS_TOKG) + ((size_t)(R0 + 2 * lane) * 4 + h) * 4;
        *(f32x4*)tg = (f32x4){aa[0], bb[0], mx[0], 0.f}; *(f32x4*)(tg + 16) = (f32x4){aa[1], bb[1], mx[1], 0.f};
        if (lane == 0) *(f32x2*)((float*)(ws + WS_CSUM) + 2 * u) = (f32x2){Bc, Ml};
    }
    __syncthreads();
    const int wr = wave >> 1, wcn = wave & 1, fr = lane & 15, fq = lane >> 4;
    {
        f32x4 aq[2][4], ak[2][4];
#pragma unroll
        for (int mi = 0; mi < 2; ++mi)
#pragma unroll
            for (int ni = 0; ni < 4; ++ni) { aq[mi][ni] = (f32x4){0.f, 0.f, 0.f, 0.f}; ak[mi][ni] = (f32x4){0.f, 0.f, 0.f, 0.f}; }
        const bf16* Wq = (const bf16*)(ws + WS_WMQ) + h * 16384; const bf16* Wk = (const bf16*)(ws + WS_WMK) + h * 16384;
#pragma unroll
        for (int kk = 0; kk < 4; ++kk) { bf16x8 a[2];
#pragma unroll
            for (int mi = 0; mi < 2; ++mi) a[mi] = *(const LAS bf16x8*)(CA + (32 * wr + 16 * mi + fr) * 136 + 32 * kk + 8 * fq);
#pragma unroll
            for (int ni = 0; ni < 4; ++ni) { const int off = (64 * wcn + 16 * ni + fr) * 128 + 32 * kk + 8 * fq;
                const bf16x8 bq = *(const bf16x8*)(Wq + off), bk = *(const bf16x8*)(Wk + off);
#pragma unroll
                for (int mi = 0; mi < 2; ++mi) { aq[mi][ni] = MFMA16(a[mi], bq, aq[mi][ni]); ak[mi][ni] = MFMA16(a[mi], bk, ak[mi][ni]); } } }
        bf16* QM = (bf16*)(ws + WS_QM); bf16* KM = (bf16*)(ws + WS_KM);
#pragma unroll
        for (int mi = 0; mi < 2; ++mi)
#pragma unroll
            for (int ni = 0; ni < 4; ++ni) { const int col = 64 * wcn + 16 * ni + fr, rowb = 32 * wr + 16 * mi + 4 * fq; float kw[4];
#pragma unroll
                for (int r = 0; r < 4; ++r) { const int row = rowb + r; const size_t o = (size_t)(R0 + row) * 512 + 128 * h + col;
                    QM[o] = f2bf1(aq[mi][ni][r]); const float kv = ak[mi][ni][r] * KSCALE; KM[o] = f2bf1(kv); kw[r] = SAMPLE ? 0.f : kv * wk[row]; }
                if (!SAMPLE) { v2u o2; o2.x = pk2(kw[0], kw[1]); o2.y = pk2(kw[2], kw[3]); *(LAS v2u*)(KT + col * 136 + rowb) = o2; } }
    }
    __syncthreads();
    if (!SAMPLE) {
        f32x4 dc[2][4];
#pragma unroll
        for (int mi = 0; mi < 2; ++mi)
#pragma unroll
            for (int ni = 0; ni < 4; ++ni) dc[mi][ni] = (f32x4){0.f, 0.f, 0.f, 0.f};
#pragma unroll
        for (int kk = 0; kk < 4; ++kk) { bf16x8 a[2], bfr[4];
#pragma unroll
            for (int mi = 0; mi < 2; ++mi) a[mi] = *(const LAS bf16x8*)(VT + (32 * wr + 16 * mi + fr) * 136 + 32 * kk + 8 * fq);
#pragma unroll
            for (int ni = 0; ni < 4; ++ni) bfr[ni] = *(const LAS bf16x8*)(KT + (64 * wcn + 16 * ni + fr) * 136 + 32 * kk + 8 * fq);
#pragma unroll
            for (int mi = 0; mi < 2; ++mi)
#pragma unroll
                for (int ni = 0; ni < 4; ++ni) dc[mi][ni] = MFMA16(a[mi], bfr[ni], dc[mi][ni]); }
        float* DCu = (float*)(ws + WS_DC) + (size_t)u * 16384;
#pragma unroll
        for (int mi = 0; mi < 2; ++mi)
#pragma unroll
            for (int ni = 0; ni < 4; ++ni)
#pragma unroll
                for (int r = 0; r < 4; ++r) DCu[(32 * wr + 16 * mi + 4 * fq + r) * 128 + 64 * wcn + 16 * ni + fr] = dc[mi][ni][r];
        if (tid < 128) { float s = 0.f;
            for (int ss = 0; ss < 128; ss += 2) { const unsigned w = *(const LAS unsigned*)(KT + tid * 136 + ss); s += bflo(w) + bfhi(w); }
            ((float*)(ws + WS_DN))[u * 128 + tid] = s; }
    }
    __syncthreads();
}

__device__ __forceinline__ void attn_core(const LAS bf16* Ks, int ksd, const LAS bf16* VT, int vsd, int p0, int qi, int smin, const bf16x8 (&Qf)[2], float slope, float sink,
                                          const float* g_attn_h, bf16* yrow, bool store, int fr, int fq) {
    f32x4 gat[4];
#pragma unroll
    for (int dt = 0; dt < 4; ++dt) gat[dt] = *(const f32x4*)(g_attn_h + 16 * dt + 4 * fq);
    float sc[5][8]; float mxv = -INFINITY;
#pragma unroll
    for (int pi = 0; pi < 5; ++pi) { const int pp = p0 + pi; f32x4 s0 = {0.f, 0.f, 0.f, 0.f}, s1 = {0.f, 0.f, 0.f, 0.f};
#pragma unroll
        for (int kk = 0; kk < 2; ++kk) { const bf16x8 a0 = *(const LAS bf16x8*)(Ks + (32 * pp + fr) * ksd + 32 * kk + 8 * fq), a1 = *(const LAS bf16x8*)(Ks + (32 * pp + 16 + fr) * ksd + 32 * kk + 8 * fq);
            s0 = MFMA16(a0, Qf[kk], s0); s1 = MFMA16(a1, Qf[kk], s1); }
#pragma unroll
        for (int r = 0; r < 4; ++r) {
            { const int s = 32 * pp + 4 * fq + r, dist = 128 + qi - s; const bool ok = dist >= 0 && dist < 128 && s >= smin; const float v = ok ? s0[r] * 0.125f - slope * (float)dist : -INFINITY; sc[pi][r] = v; mxv = fmaxf(mxv, v); }
            { const int s = 32 * pp + 16 + 4 * fq + r, dist = 128 + qi - s; const bool ok = dist >= 0 && dist < 128 && s >= smin; const float v = ok ? s1[r] * 0.125f - slope * (float)dist : -INFINITY; sc[pi][4 + r] = v; mxv = fmaxf(mxv, v); }
        } }
    mxv = fmaxf(quad_max(mxv), sink);
    float psum = 0.f; f32x4 o[4];
#pragma unroll
    for (int dt = 0; dt < 4; ++dt) o[dt] = (f32x4){0.f, 0.f, 0.f, 0.f};
#pragma unroll
    for (int pi = 0; pi < 5; ++pi) { const int pp = p0 + pi; float pv[8];
#pragma unroll
        for (int i = 0; i < 8; ++i) { pv[i] = __expf(sc[pi][i] - mxv); psum += pv[i]; }
        const bf16x8 Pf = pack8(pv);
#pragma unroll
        for (int dt = 0; dt < 4; ++dt) { const LAS bf16* vp = VT + (16 * dt + fr) * vsd + 32 * pp + 4 * fq;
            o[dt] = MFMA16(mk8(*(const LAS v2u*)vp, *(const LAS v2u*)(vp + 16)), Pf, o[dt]); } }
    psum = quad_sum(psum);
    const float inv = 1.0f / (psum + __expf(sink - mxv));
    float sum = 0.f;
#pragma unroll
    for (int dt = 0; dt < 4; ++dt) { o[dt] = o[dt] * inv; sum += (o[dt][0] + o[dt][1]) + (o[dt][2] + o[dt][3]); }
    const float mean = quad_sum(sum) * (1.0f / 64.0f); float q = 0.f;
#pragma unroll
    for (int dt = 0; dt < 4; ++dt) { o[dt] = o[dt] - mean; q += (o[dt][0] * o[dt][0] + o[dt][1] * o[dt][1]) + (o[dt][2] * o[dt][2] + o[dt][3] * o[dt][3]); }
    const float rstd = 1.0f / sqrtf(quad_sum(q) * (1.0f / 64.0f) + LN_EPS);
    if (store) {
#pragma unroll
        for (int dt = 0; dt < 4; ++dt) o[dt] = o[dt] * rstd * gat[dt];
#pragma unroll
        for (int dt = 0; dt < 4; ++dt) { const int d0 = 16 * dt + 4 * fq; v2u w; w.x = pk2(o[dt][0], o[dt][1]); w.y = pk2(o[dt][2], o[dt][3]); *(v2u*)(yrow + d0) = w; }
    }
}
__device__ __forceinline__ void unit_attn_prompt(const Params& p, LAS unsigned char* lds, int tid, int b, int blk, int head) {
    const int lane = tid & 63, wave = __builtin_amdgcn_readfirstlane(tid >> 6), fr = lane & 15, fq = lane >> 4, kvh = head >> 2;
    LAS bf16* Ks = (LAS bf16*)lds; LAS bf16* VT = (LAS bf16*)(lds + 36864);
    const bf16* Z = (const bf16*)(p.ws + WS_Z);
    { const int key = tid >> 1, half = tid & 1, R = row_of(b, 128 * (blk - 1) + key);
#pragma unroll
      for (int i = 0; i < 4; ++i) *(LAS v4u*)(Ks + key * 72 + 32 * half + 8 * i) = *(const v4u*)(Z + (size_t)R * ZW + ZC_K + 64 * kvh + 32 * half + 8 * i); }
    { const int kg = tid >> 3, dg = tid & 7; v4u raw[4];
#pragma unroll
      for (int r = 0; r < 4; ++r) raw[r] = *(const v4u*)(Z + (size_t)row_of(b, 128 * (blk - 1) + 4 * kg + r) * ZW + ZC_V + 64 * kvh + 8 * dg);
      store_vt(VT, 264, 8 * dg, 4 * kg, raw); }
    const int qi = 16 * wave + fr, Rq = b * 4096 + 128 * (blk - 1) + qi;
    bf16x8 Qf[2];
#pragma unroll
    for (int kk = 0; kk < 2; ++kk) Qf[kk] = *(const bf16x8*)(Z + (size_t)Rq * ZW + 64 * head + 32 * kk + 8 * fq);
    __syncthreads();
    attn_core(Ks, 72, VT, 264, wave >> 1, qi, 112 - 128 * (blk - 1), Qf, exp2f(-(float)(head + 1)), p.in[I_SINK][head], p.in[I_GATT] + 64 * head,
              (bf16*)(p.ws + WS_Y) + (size_t)Rq * 1024 + 64 * head, true, fr, fq);
    __syncthreads();
}
__device__ __forceinline__ void unit_attn_sample(const Params& p, LAS unsigned char* lds, int tid, int n) {
    const int lane = tid & 63, wave = __builtin_amdgcn_readfirstlane(tid >> 6), fr = lane & 15, fq = lane >> 4, head = wave, kvh = head >> 2;
    LAS bf16* Ks = (LAS bf16*)lds; LAS bf16* VT = (LAS bf16*)(lds + 46080);
    const bf16* Z = (const bf16*)(p.ws + WS_Z);
    for (int t = tid; t < 2560; t += NTHR) { const int c = t & 7, key = (t >> 3) % 160, kv = t / 1280; v4u o = {0u, 0u, 0u, 0u};
        if (key < 128) { const float* s = p.in[I_CK] + ((size_t)(n * 128 + key) * 2 + kv) * 64 + 8 * c; const f32x4 a = *(const f32x4*)s, bq = *(const f32x4*)(s + 4);
            o.x = pk2(a[0], a[1]); o.y = pk2(a[2], a[3]); o.z = pk2(bq[0], bq[1]); o.w = pk2(bq[2], bq[3]); }
        else if (key < 136) o = *(const v4u*)(Z + (size_t)(R_SAMPLE + 8 * n + key - 128) * ZW + ZC_K + 64 * kv + 8 * c);
        *(LAS v4u*)(Ks + (kv * 160 + key) * 72 + 8 * c) = o; }
    for (int t = tid; t < 640; t += NTHR) { const int dg = t & 7, kg = (t >> 3) % 40, kv = t / 320; v4u raw[4];
#pragma unroll
        for (int r = 0; r < 4; ++r) { const int key = 4 * kg + r; v4u o = {0u, 0u, 0u, 0u};
            if (key < 128) { const float* s = p.in[I_CV] + ((size_t)(n * 128 + key) * 2 + kv) * 64 + 8 * dg; const f32x4 a = *(const f32x4*)s, bq = *(const f32x4*)(s + 4);
                o.x = pk2(a[0], a[1]); o.y = pk2(a[2], a[3]); o.z = pk2(bq[0], bq[1]); o.w = pk2(bq[2], bq[3]); }
            else if (key < 136) o = *(const v4u*)(Z + (size_t)(R_SAMPLE + 8 * n + key - 128) * ZW + ZC_V + 64 * kv + 8 * dg);
            raw[r] = o; }
        store_vt(VT + kv * 64 * 168, 168, 8 * dg, 4 * kg, raw); }
    __syncthreads();
    const int qi = fr, Rq = R_SAMPLE + 8 * n + (fr & 7);
    bf16x8 Qf[2];
#pragma unroll
    for (int kk = 0; kk < 2; ++kk) { v4u q = *(const v4u*)(Z + (size_t)Rq * ZW + 64 * head + 32 * kk + 8 * fq); if (fr >= 8) q = (v4u){0u, 0u, 0u, 0u}; Qf[kk] = __builtin_bit_cast(bf16x8, q); }
    attn_core(Ks + kvh * 160 * 72, 72, VT + kvh * 64 * 168, 168, 0, qi, 0, Qf, exp2f(-(float)(head + 1)), p.in[I_SINK][head], p.in[I_GATT] + 64 * head,
              (bf16*)(p.ws + WS_Y) + (size_t)Rq * 1024 + 64 * head, fr < 8, fr, fq);
    __syncthreads();
}

__device__ __forceinline__ void unit_mlstm_sample(const Params& p, LAS unsigned char* lds, int tid, int n0, int h) {
    const int lane = tid & 63, wave = __builtin_amdgcn_readfirstlane(tid >> 6);
    constexpr int PST = 5504;
#define SB_PTRS(pp) LAS float* ca = (LAS float*)lds + (pp) * PST; LAS float* qs = ca + 1024; LAS float* ks = qs + 1024; LAS float* vs = ks + 1024; LAS float* hs = vs + 1024; LAS float* sm = hs + 1024; \
    LAS float* s_li = sm, *s_lf = sm + 8, *s_ga = sm + 16, *s_mu = sm + 24, *s_wi = sm + 32, *s_mt = sm + 40, *s_wk = sm + 48, *s_nq = sm + 56, *s_Sd = sm + 64, *s_sc = sm + 128, *s_raw = sm + 136; \
    (void)ca; (void)qs; (void)ks; (void)vs; (void)hs; (void)s_li; (void)s_lf; (void)s_ga; (void)s_mu; (void)s_wi; (void)s_mt; (void)s_wk; (void)s_nq; (void)s_Sd; (void)s_sc; (void)s_raw;
    const bf16* Z = (const bf16*)(p.ws + WS_Z); const float* gates = (const float*)(p.ws + WS_GATES);
    const int vv = tid >> 2, part = tid & 3;
    float C[2][32]; float og0[2], og1[2];
#pragma unroll
    for (int pp = 0; pp < 2; ++pp) { const int n = n0 + 64 * pp, nh = n * 4 + h, R0 = R_SAMPLE + 8 * n;
        const float* cp = p.in[I_SC] + ((size_t)nh * 128 + vv) * 128 + 32 * part;
#pragma unroll
        for (int i = 0; i < 8; ++i) { const f32x4 c4 = *(const f32x4*)(cp + 4 * i); C[pp][4 * i] = c4[0]; C[pp][4 * i + 1] = c4[1]; C[pp][4 * i + 2] = c4[2]; C[pp][4 * i + 3] = c4[3]; }
        og0[pp] = bf2f(Z[(size_t)(R0 + 2 * part) * ZW + ZC_O + 128 * h + vv]); og1[pp] = bf2f(Z[(size_t)(R0 + 2 * part + 1) * ZW + ZC_O + 128 * h + vv]); }
#pragma unroll
    for (int pp = 0; pp < 2; ++pp) { SB_PTRS(pp) const int n = n0 + 64 * pp, nh = n * 4 + h, R0 = R_SAMPLE + 8 * n;
        const int l = tid >> 6, cc = tid & 63; const size_t o = (size_t)(R0 + l) * 512 + 128 * h + 2 * cc;
        const unsigned qw = *(const unsigned*)((const bf16*)(p.ws + WS_QM) + o), kw = *(const unsigned*)((const bf16*)(p.ws + WS_KM) + o);
        const unsigned vw = *(const unsigned*)(Z + (size_t)(R0 + l) * ZW + ZC_VM + 128 * h + 2 * cc);
        qs[l * 128 + 2 * cc] = bflo(qw); qs[l * 128 + 2 * cc + 1] = bfhi(qw); ks[l * 128 + 2 * cc] = bflo(kw); ks[l * 128 + 2 * cc + 1] = bfhi(kw);
        vs[l * 128 + 2 * cc] = bflo(vw); vs[l * 128 + 2 * cc + 1] = bfhi(vw);
        if (tid < 128) ca[tid] = p.in[I_SN][(size_t)nh * 128 + tid];
        if (tid < 8) { const float* g = gates + (size_t)(R0 + tid) * 8; s_li[tid] = g[h] + p.in[I_BI][h]; s_lf[tid] = logsig_f(g[4 + h] + p.in[I_BF][h]); }
    }
    __syncthreads();
    if (tid < 16) {
        const int pp = tid >> 3, l8 = tid & 7; SB_PTRS(pp) const int nh = (n0 + 64 * pp) * 4 + h;
        const float m_s = p.in[I_SM][nh]; float bsum = 0.f, mxr = -INFINITY, a = 0.f;
        for (int l = 0; l <= l8; ++l) { bsum += s_lf[l]; a = s_li[l] - bsum; mxr = fmaxf(mxr, a); }
        const float mu = fmaxf(m_s, mxr), mu_last = __shfl(mu, 8 * pp + 7), mt = bsum + mu;
        s_ga[l8] = a; s_mu[l8] = mu; s_wi[l8] = __expf(m_s - mu); s_mt[l8] = mt; s_wk[l8] = __expf(a - mu_last);
        if (l8 == 7) { s_sc[0] = __expf(m_s - mu_last); p.out[O_SM + nh] = mt; }
    }
    if (tid >= 64 && tid < 64 + 288) {
        const int id2 = (tid - 64) >> 1, pq = tid & 1, pp = id2 >= 72 ? 1 : 0, id = id2 - 72 * pp; SB_PTRS(pp)
        const LAS float* ap = qs + (id < 64 ? (id >> 3) : (id - 64)) * 128 + 64 * pq; const LAS float* bp = (id < 64 ? ks + (id & 7) * 128 : ca) + 64 * pq;
        float dot = 0.f;
#pragma unroll
        for (int k = 0; k < 64; ++k) dot += ap[k] * bp[k];
        dot += __shfl_xor(dot, 1);
        if (pq == 0) s_raw[id] = dot; }
    __syncthreads();
    if (tid < 144) { const int pp = tid >= 72 ? 1 : 0, r = tid - 72 * pp; SB_PTRS(pp)
        if (r < 64) { const int t = r >> 3, s2 = r & 7; s_Sd[r] = (s2 <= t) ? s_raw[r] * __expf(s_ga[s2] - s_mu[t]) : 0.f; }
        else s_nq[r - 64] = s_raw[r]; }
    __syncthreads();
#pragma unroll
    for (int pp = 0; pp < 2; ++pp) { SB_PTRS(pp) const int nh = (n0 + 64 * pp) * 4 + h; const float decay = s_sc[0];
#pragma unroll
        for (int t = 0; t < 8; ++t) { float s = 0.f;
#pragma unroll
            for (int k = 0; k < 32; ++k) s += C[pp][k] * qs[t * 128 + 32 * part + k];
            s += __shfl_xor(s, 1); s += __shfl_xor(s, 2);
            if ((t >> 1) == part) { float num = s_wi[t] * s, den = s_wi[t] * s_nq[t];
#pragma unroll
                for (int s2 = 0; s2 < 8; ++s2) { const float w = s_Sd[t * 8 + s2]; num += w * vs[s2 * 128 + vv]; den += w; }
                const float hval = num / fmaxf(fabsf(den), __expf(-s_mt[t]));
                hs[t * 128 + vv] = sigmoid_f((t & 1) ? og1[pp] : og0[pp]) * hval; } }
        float wv[8];
#pragma unroll
        for (int s2 = 0; s2 < 8; ++s2) wv[s2] = s_wk[s2] * vs[s2 * 128 + vv];
        float* op = p.out + O_SC + ((size_t)nh * 128 + vv) * 128 + 32 * part;
#pragma unroll
        for (int i = 0; i < 8; ++i) { f32x4 o4;
#pragma unroll
            for (int e = 0; e < 4; ++e) { float acc = decay * C[pp][4 * i + e];
#pragma unroll
                for (int s2 = 0; s2 < 8; ++s2) acc += wv[s2] * ks[s2 * 128 + 32 * part + 4 * i + e];
                o4[e] = acc; }
            *(f32x4*)(op + 4 * i) = o4; }
        if (tid < 128) { float acc = decay * ca[tid];
#pragma unroll
            for (int s2 = 0; s2 < 8; ++s2) acc += s_wk[s2] * ks[s2 * 128 + tid];
            p.out[O_SN + (size_t)nh * 128 + tid] = acc; }
    }
    __syncthreads();
#pragma unroll
    for (int pp = 0; pp < 2; ++pp) { SB_PTRS(pp) const int R0 = R_SAMPLE + 8 * (n0 + 64 * pp);
        const int t = wave; const float v0 = hs[t * 128 + 2 * lane], v1 = hs[t * 128 + 2 * lane + 1];
        const float mean = wave_sum(v0 + v1) * (1.0f / 128.0f); const float d0 = v0 - mean, d1 = v1 - mean;
        const float rstd = 1.0f / sqrtf(wave_sum(d0 * d0 + d1 * d1) * (1.0f / 128.0f) + LN_EPS);
        const float* g = p.in[I_GML] + 128 * h + 2 * lane;
        *(unsigned*)((bf16*)(p.ws + WS_Y) + (size_t)(R0 + t) * 1024 + 512 + 128 * h + 2 * lane) = pk2(d0 * rstd * g[0], d1 * rstd * g[1]);
    }
    __syncthreads();
#undef SB_PTRS
}

__device__ __forceinline__ void p2_copies(const Params& p, int tid) {
    const bf16* Z = (const bf16*)(p.ws + WS_Z); float* out = p.out;
    const int gt = blockIdx.x * NTHR + tid, GS = gridDim.x * NTHR;
    constexpr int NA = 2 * 128 * 3840;
    for (int i0 = gt; i0 < NA; i0 += 4 * GS) { f32x4 v[4]; size_t dst[4];
#pragma unroll
        for (int k = 0; k < 4; ++k) { const int i = i0 + k * GS; if (i < NA) { const int which = i >= NA / 2, r = i - which * (NA / 2), n = r / 3840, o4 = r - n * 3840;
            v[k] = *(const f32x4*)(p.in[which ? I_CV : I_CK] + (size_t)n * 16384 + 1024 + 4 * o4); dst[k] = (which ? O_SV : O_SK) + (size_t)n * 16384 + 4 * o4; } }
#pragma unroll
        for (int k = 0; k < 4; ++k) if (i0 + k * GS < NA) *(f32x4*)(out + dst[k]) = v[k]; }
    constexpr int B0 = 2 * 16384, B1 = B0 + 1536, B2 = B1 + 2 * 32768, NBq = B2 + 49152;
    for (int i0 = gt; i0 < NBq; i0 += 2 * GS) { v2u raw[2]; size_t dstv[2];
#pragma unroll
        for (int k = 0; k < 2; ++k) { const int i = i0 + k * GS; if (i < NBq) {
            int row, col; size_t dst;
            if (i < B0) { const int which = i >= 16384, r = i & 16383, b = r >> 12, w = (r >> 5) & 127, c4 = r & 31; row = b * 4096 + 3968 + w; col = (which ? ZC_V : ZC_K) + 4 * c4; dst = (which ? O_PV : O_PK) + (size_t)r * 4; }
            else if (i < B1) { const int r = i - B0, b = r / 384, rr = (r / 128) % 3, c4 = r & 127; row = b * 4096 + 4093 + rr; col = ZC_C + 4 * c4; dst = O_PCONV + (size_t)r * 4; }
            else if (i < B2) { const int r0 = i - B1, which = r0 >= 32768, r = r0 & 32767, n = r >> 8, w = (r >> 5) & 7, c4 = r & 31; row = R_SAMPLE + 8 * n + w; col = (which ? ZC_V : ZC_K) + 4 * c4;
                dst = (which ? O_SV : O_SK) + (size_t)n * 16384 + (size_t)(120 + w) * 128 + 4 * c4; }
            else { const int r = i - B2, n = r / 384, rr = (r / 128) % 3, c4 = r & 127; row = R_SAMPLE + 8 * n + 5 + rr; col = ZC_C + 4 * c4; dst = O_SCONV + (size_t)r * 4; }
            raw[k] = *(const v2u*)(Z + (size_t)row * ZW + col); dstv[k] = dst; } }
#pragma unroll
        for (int k = 0; k < 2; ++k) if (i0 + k * GS < NBq) *(f32x4*)(out + dstv[k]) = (f32x4){bflo(raw[k].x), bfhi(raw[k].x), bflo(raw[k].y), bfhi(raw[k].y)}; }
}

__device__ __forceinline__ void p3_scan(const Params& p, int tid) {
    unsigned char* ws = p.ws; const float* DC = (const float*)(ws + WS_DC); const float* DN = (const float*)(ws + WS_DN); const float* CSUM = (const float*)(ws + WS_CSUM);
    float* SCAL = (float*)(ws + WS_SCAL); bf16* CS = (bf16*)(ws + WS_CS); float* NS = (float*)(ws + WS_NS);
    for (int g = blockIdx.x * NTHR + tid; g < 131072; g += gridDim.x * NTHR) {
        const int bh = g >> 13, b = bh >> 2, h = bh & 3, e2 = g & 8191;
        float c0 = 0.f, c1 = 0.f, m = 0.f;
        for (int jb = 0; jb < 33; jb += 11) { f32x2 d[11], cs[11];
#pragma unroll
            for (int i = 0; i < 11; ++i) { const int u = (b * 33 + jb + i) * 4 + h; d[i] = *(const f32x2*)(DC + (size_t)u * 16384 + 2 * e2); cs[i] = *(const f32x2*)(CSUM + 2 * u); }
#pragma unroll
            for (int i = 0; i < 11; ++i) { const int u = (b * 33 + jb + i) * 4 + h; *(unsigned*)(CS + (size_t)u * 16384 + 2 * e2) = pk2(c0, c1);
                const float Ml = cs[i][1], mu = fmaxf(m, Ml), dec = __expf(m - mu), scl = __expf(Ml - mu);
                if (e2 == 0) *(f32x4*)(SCAL + u * 4) = (f32x4){m, dec, cs[i][0] + mu, 0.f};
                c0 = dec * c0 + scl * d[i][0]; c1 = dec * c1 + scl * d[i][1]; m = cs[i][0] + mu; } }
        *(f32x2*)(p.out + O_PC + (size_t)bh * 16384 + 2 * e2) = (f32x2){c0, c1};
        if (e2 == 0) p.out[O_PM + bh] = m;
        if (e2 < 64) { float n0 = 0.f, n1 = 0.f; m = 0.f;
            for (int jb = 0; jb < 33; jb += 11) { f32x2 d[11], cs[11];
#pragma unroll
                for (int i = 0; i < 11; ++i) { const int u = (b * 33 + jb + i) * 4 + h; d[i] = *(const f32x2*)(DN + u * 128 + 2 * e2); cs[i] = *(const f32x2*)(CSUM + 2 * u); }
#pragma unroll
                for (int i = 0; i < 11; ++i) { const int u = (b * 33 + jb + i) * 4 + h; *(f32x2*)(NS + u * 128 + 2 * e2) = (f32x2){n0, n1};
                    const float Ml = cs[i][1], mu = fmaxf(m, Ml), dec = __expf(m - mu), scl = __expf(Ml - mu);
                    n0 = dec * n0 + scl * d[i][0]; n1 = dec * n1 + scl * d[i][1]; m = cs[i][0] + mu; } }
            *(f32x2*)(p.out + O_PN + bh * 128 + 2 * e2) = (f32x2){n0, n1}; }
    }
}

__device__ __forceinline__ void unit_mlstm_b(const Params& p, LAS unsigned char* lds, int tid, int b, int j, int h) {
    const int lane = tid & 63, wave = __builtin_amdgcn_readfirstlane(tid >> 6), fr = lane & 15, fq = lane >> 4;
    LAS bf16* KMs = (LAS bf16*)lds; LAS bf16* VT = (LAS bf16*)(lds + 34816); LAS bf16* CSs = (LAS bf16*)(lds + 69632);
    LAS float* aA = (LAS float*)(lds + 104448); LAS float* bA = aA + 128; LAS float* mxA = bA + 128; LAS float* nsA = mxA + 128;
    unsigned char* ws = p.ws;
    const bf16* Z = (const bf16*)(ws + WS_Z); const bf16* QM = (const bf16*)(ws + WS_QM); const bf16* KM = (const bf16*)(ws + WS_KM); const bf16* CS = (const bf16*)(ws + WS_CS);
    const int u = (b * 33 + j) * 4 + h, R0 = b * 4096 + 128 * (j - 1);
    { const int row = tid >> 2, part = tid & 3;
#pragma unroll
      for (int i = 0; i < 4; ++i) { *(LAS v4u*)(KMs + row * 136 + 32 * part + 8 * i) = *(const v4u*)(KM + (size_t)(R0 + row) * 512 + 128 * h + 32 * part + 8 * i);
          *(LAS v4u*)(CSs + row * 136 + 32 * part + 8 * i) = *(const v4u*)(CS + (size_t)u * 16384 + row * 128 + 32 * part + 8 * i); } }
    { const int rg = tid >> 4, c8 = tid & 15; v4u raw[4];
#pragma unroll
      for (int r = 0; r < 4; ++r) raw[r] = *(const v4u*)(Z + (size_t)(R0 + 4 * rg + r) * ZW + ZC_VM + 128 * h + 8 * c8);
      store_vt(VT, 136, 8 * c8, 4 * rg, raw); }
    if (tid < 128) { const f32x4 tg = *(const f32x4*)((const float*)(ws + WS_TOKG) + ((size_t)(R0 + tid) * 4 + h) * 4); aA[tid] = tg[0]; bA[tid] = tg[1]; mxA[tid] = tg[2]; }
    else if (tid < 256) nsA[tid - 128] = ((const float*)(ws + WS_NS))[u * 128 + tid - 128];
    const float m_s = ((const float*)(ws + WS_SCAL))[u * 4];
    const int t = 16 * wave + fr, Rt = R0 + t;
    bf16x8 Qf[4]; v2u og[8];
#pragma unroll
    for (int kk = 0; kk < 4; ++kk) Qf[kk] = *(const bf16x8*)(QM + (size_t)Rt * 512 + 128 * h + 32 * kk + 8 * fq);
#pragma unroll
    for (int vt = 0; vt < 8; ++vt) og[vt] = *(const v2u*)(Z + (size_t)Rt * ZW + ZC_O + 128 * h + 16 * vt + 4 * fq);
    f32x4 gml[8];
#pragma unroll
    for (int vt = 0; vt < 8; ++vt) gml[vt] = *(const f32x4*)(p.in[I_GML] + 128 * h + 16 * vt + 4 * fq);
    __syncthreads();
    const float mu_t = fmaxf(m_s, mxA[t]), w_int = __expf(m_s - mu_t), m_t = bA[t] + mu_t;
    f32x4 oi[8], oe[8];
#pragma unroll
    for (int vt = 0; vt < 8; ++vt) { oi[vt] = (f32x4){0.f, 0.f, 0.f, 0.f}; oe[vt] = (f32x4){0.f, 0.f, 0.f, 0.f}; }
    float dsum = 0.f;
    const int npair = (wave >> 1) + 1;
    for (int pp = 0; pp < npair; ++pp) {
        f32x4 s0 = {0.f, 0.f, 0.f, 0.f}, s1 = {0.f, 0.f, 0.f, 0.f};
#pragma unroll
        for (int kk = 0; kk < 4; ++kk) { const bf16x8 a0 = *(const LAS bf16x8*)(KMs + (32 * pp + fr) * 136 + 32 * kk + 8 * fq), a1 = *(const LAS bf16x8*)(KMs + (32 * pp + 16 + fr) * 136 + 32 * kk + 8 * fq);
            s0 = MFMA16(a0, Qf[kk], s0); s1 = MFMA16(a1, Qf[kk], s1); }
        float pv[8];
#pragma unroll
        for (int r = 0; r < 4; ++r) { const int sa = 32 * pp + 4 * fq + r, sb = sa + 16;
            pv[r] = (sa <= t) ? s0[r] * __expf(aA[sa] - mu_t) : 0.f; pv[4 + r] = (sb <= t) ? s1[r] * __expf(aA[sb] - mu_t) : 0.f; dsum += pv[r] + pv[4 + r]; }
        const bf16x8 Pf = pack8(pv);
#pragma unroll
        for (int vt = 0; vt < 8; ++vt) { const LAS bf16* vp = VT + (16 * vt + fr) * 136 + 32 * pp + 4 * fq;
            oi[vt] = MFMA16(mk8(*(const LAS v2u*)vp, *(const LAS v2u*)(vp + 16)), Pf, oi[vt]); }
    }
#pragma unroll
    for (int kk = 0; kk < 4; ++kk)
#pragma unroll
        for (int vt = 0; vt < 8; ++vt) oe[vt] = MFMA16(*(const LAS bf16x8*)(CSs + (16 * vt + fr) * 136 + 32 * kk + 8 * fq), Qf[kk], oe[vt]);
    float nq = 0.f;
#pragma unroll
    for (int kk = 0; kk < 4; ++kk)
#pragma unroll
        for (int jx = 0; jx < 8; ++jx) nq += nsA[32 * kk + 8 * fq + jx] * bf2f((unsigned short)Qf[kk][jx]);
    nq = quad_sum(nq); dsum = quad_sum(dsum);
    const float den = dsum + w_int * nq, inv = 1.0f / fmaxf(fabsf(den), __expf(-m_t));
    float sum = 0.f;
#pragma unroll
    for (int vt = 0; vt < 8; ++vt) { const v2u raw = og[vt];
        const float op[4] = {bflo(raw.x), bfhi(raw.x), bflo(raw.y), bfhi(raw.y)};
#pragma unroll
        for (int r = 0; r < 4; ++r) { const float hv = (oi[vt][r] + w_int * oe[vt][r]) * inv * sigmoid_f(op[r]); oi[vt][r] = hv; sum += hv; } }
    const float mean = quad_sum(sum) * (1.0f / 128.0f); float q = 0.f;
#pragma unroll
    for (int vt = 0; vt < 8; ++vt) { oi[vt] = oi[vt] - mean; q += (oi[vt][0] * oi[vt][0] + oi[vt][1] * oi[vt][1]) + (oi[vt][2] * oi[vt][2] + oi[vt][3] * oi[vt][3]); }
    const float rstd = 1.0f / sqrtf(quad_sum(q) * (1.0f / 128.0f) + LN_EPS);
    bf16* yrow = (bf16*)(ws + WS_Y) + (size_t)Rt * 1024 + 512 + 128 * h;
#pragma unroll
    for (int vt = 0; vt < 8; ++vt) oi[vt] = oi[vt] * rstd * gml[vt];
#pragma unroll
    for (int vt = 0; vt < 8; ++vt) { const int v0 = 16 * vt + 4 * fq; v2u w; w.x = pk2(oi[vt][0], oi[vt][1]); w.y = pk2(oi[vt][2], oi[vt][3]); *(v2u*)(yrow + v0) = w; }
    __syncthreads();
}

__device__ __forceinline__ void ln_load_bf16(const bf16* xrow, int lane, f32x4 (&v)[4]) {
#pragma unroll
    for (int jx = 0; jx < 4; ++jx) { const v2u w = ((const v2u*)xrow)[lane + 64 * jx]; v[jx] = (f32x4){bflo(w.x), bfhi(w.x), bflo(w.y), bfhi(w.y)}; }
}
__device__ __forceinline__ void ln_rows(const bf16* x, float* of, bf16* ob, const float* g, const float* bta, const float* res, float* ofS, const float* sl0, int n0, const float* sl1, int n1, int tid) {
    const int lane = tid & 63, wave = __builtin_amdgcn_readfirstlane(tid >> 6);
    const int RS = gridDim.x * 8;
    f32x4 vn[4];
    { const int R = blockIdx.x * 8 + wave; if (R < R_SAMPLE) ln_load_bf16(x + (size_t)R * 1024, lane, vn); }
    for (int R = blockIdx.x * 8 + wave; R < MMAIN; R += RS) {
        f32x4 v[4]; float s = 0.f; f32x4* orow = nullptr;
        if (R < R_SAMPLE) { if (of) orow = (f32x4*)(of + (size_t)R * 1024) + lane;
#pragma unroll
            for (int jx = 0; jx < 4; ++jx) v[jx] = vn[jx];
            if (R + RS < R_SAMPLE) ln_load_bf16(x + (size_t)(R + RS) * 1024, lane, vn);
        } else { const size_t ro = (size_t)(R - R_SAMPLE) * 1024; const f32x4* xr = (const f32x4*)(res + ro) + lane; orow = (f32x4*)(ofS + ro) + lane;
#pragma unroll
            for (int jx = 0; jx < 4; ++jx) v[jx] = xr[64 * jx] * ALPHA;
            for (int sidx = 0; sidx < n0; ++sidx) { const f32x4* sr = (const f32x4*)(sl0 + (size_t)sidx * 1048576 + ro) + lane;
#pragma unroll
                for (int jx = 0; jx < 4; ++jx) v[jx] += sr[64 * jx]; }
            for (int sidx = 0; sidx < n1; ++sidx) { const f32x4* sr = (const f32x4*)(sl1 + (size_t)sidx * 1048576 + ro) + lane;
#pragma unroll
                for (int jx = 0; jx < 4; ++jx) v[jx] += sr[64 * jx]; }
        }
#pragma unroll
        for (int jx = 0; jx < 4; ++jx) s += (v[jx][0] + v[jx][1]) + (v[jx][2] + v[jx][3]);
        const float mean = wave_sum(s) * (1.0f / 1024.0f); float s2 = 0.f;
#pragma unroll
        for (int jx = 0; jx < 4; ++jx) { v[jx] = v[jx] - mean; s2 += (v[jx][0] * v[jx][0] + v[jx][1] * v[jx][1]) + (v[jx][2] * v[jx][2] + v[jx][3] * v[jx][3]); }
        const float rstd = 1.0f / sqrtf(wave_sum(s2) * (1.0f / 1024.0f) + LN_EPS);
#pragma unroll
        for (int jx = 0; jx < 4; ++jx) v[jx] = v[jx] * rstd * ((const f32x4*)g)[lane + 64 * jx] + ((const f32x4*)bta)[lane + 64 * jx];
#pragma unroll
        for (int jx = 0; jx < 4; ++jx) { const f32x4 y = v[jx];
            if (orow) orow[64 * jx] = y;
            if (ob) ((unsigned long long*)(ob + (size_t)R * 1024))[lane + 64 * jx] = (unsigned long long)pk2(y[0], y[1]) | ((unsigned long long)pk2(y[2], y[3]) << 32); }
    }
}

#define XB_TMO      128
#define XB_XCNT(j)  (256  + 64 * (j))
#define XB_XSUB(j)  (1280 + 64 * (j))
#define XB_XGEN(j)  (2304 + 64 * (j))
#define XB_TOP      3328
#define XB_TOPGEN   3392
#define XCD_BAR_WORDS 3456
#define XB_SPIN_CAP (1u << 18)

__device__ __forceinline__ unsigned xb_ld(unsigned* p)              { return __hip_atomic_load(p, __ATOMIC_RELAXED, __HIP_MEMORY_SCOPE_AGENT); }
__device__ __forceinline__ unsigned xb_add(unsigned* p, unsigned v) { return __hip_atomic_fetch_add(p, v, __ATOMIC_RELAXED, __HIP_MEMORY_SCOPE_AGENT); }
__device__ __forceinline__ unsigned xb_xcc_id() { return (unsigned)__builtin_amdgcn_s_getreg((3 << 11) | 20) & 0xFu; }
#define XB_SPIN(cond, bar) do { unsigned _sp = 0; while (cond) { __builtin_amdgcn_s_sleep(1); \
    if ((++_sp & 255u) == 0u) { if (xb_ld(&(bar)[XB_TMO])) break; if (_sp > XB_SPIN_CAP) { atomicAdd(&(bar)[XB_TMO], 1u); break; } } } } while (0)

struct XcdBarrier {
    unsigned* bar; unsigned x;
    volatile LAS unsigned* st;
};

__device__ __forceinline__ XcdBarrier xcd_barrier_post(unsigned* bar, volatile LAS unsigned* st) {
    XcdBarrier b; b.bar = bar; b.x = xb_xcc_id(); b.st = st;
    if (threadIdx.x == 0) (void)xb_add(&bar[XB_XCNT(b.x)], 1u);
    return b;
}
__device__ __forceinline__ void xcd_barrier_complete(unsigned* bar, unsigned x, unsigned& nloc, unsigned& nx) {
    const unsigned G = gridDim.x * gridDim.y * gridDim.z;
    unsigned sum, cnt, mine, sp = 0u;
    for (;;) {
        sum = 0u; cnt = 0u; mine = 0u;
#pragma unroll
        for (unsigned j = 0; j < 16; ++j) { const unsigned c = xb_ld(&bar[XB_XCNT(j)]); sum += c; cnt += (c > 0u) ? 1u : 0u; mine = (j == x) ? c : mine; }
        if (sum == G) break;
        __builtin_amdgcn_s_sleep(1);
        if ((++sp & 255u) == 0u) { if (xb_ld(&bar[XB_TMO])) break; if (sp > XB_SPIN_CAP) { atomicAdd(&bar[XB_TMO], 1u); break; } }
    }
    nloc = mine > 0u ? mine : 1u; nx = cnt > 0u ? cnt : 1u;
}

__device__ __forceinline__ void xcd_barrier(const XcdBarrier& b) {
    asm volatile("s_waitcnt vmcnt(0)" ::: "memory");
    __syncthreads();
    if (threadIdx.x == 0) {
        unsigned* bar = b.bar;
        __builtin_amdgcn_s_waitcnt(0);
        unsigned nloc = b.st[0], nx = b.st[1];
        if (nloc == 0u) { xcd_barrier_complete(bar, b.x, nloc, nx); b.st[0] = nloc; b.st[1] = nx; }
        const unsigned old = xb_add(&bar[XB_XSUB(b.x)], 1u);
        const unsigned gen = old / nloc;
        if (old + 1u == (gen + 1u) * nloc) {
            __builtin_amdgcn_fence(__ATOMIC_RELEASE, "agent");
            asm volatile("s_waitcnt vmcnt(0)" ::: "memory");
            const unsigned og = xb_add(&bar[XB_TOP], 1u);
            const unsigned tg = og / nx;
            if (og + 1u == (tg + 1u) * nx) xb_add(&bar[XB_TOPGEN], 1u);
            else XB_SPIN(xb_ld(&bar[XB_TOPGEN]) == tg, bar);
            __builtin_amdgcn_fence(__ATOMIC_ACQUIRE, "agent");
            xb_add(&bar[XB_XGEN(b.x)], 1u);
            asm volatile("s_waitcnt vmcnt(0)" ::: "memory");
        } else {
            XB_SPIN(xb_ld(&bar[XB_XGEN(b.x)]) == gen, bar);
            __builtin_amdgcn_fence(__ATOMIC_ACQUIRE, "agent");
            asm volatile("s_waitcnt vmcnt(0)" ::: "memory");
        }
    }
    __syncthreads();
}

constexpr int NU_MA = 528, NU_AP = 1024, NU_MS = 32, NU_AS = 128;
constexpr int NU_P2 = NU_MA + NU_AP + NU_MS + NU_AS;
constexpr int PROBE_SYNCS = 0; constexpr unsigned PROBE_REP = 0u;
__global__ void __launch_bounds__(NTHR, 2) hymba_fwd(Params p) {
    extern __shared__ __attribute__((aligned(16))) unsigned char lds_raw[];
    LAS unsigned char* lds = (LAS unsigned char*)lds_raw;
    cg::grid_group grid = cg::this_grid();
    const int tid = threadIdx.x;
    unsigned char* ws = p.ws;
    const int lo = p.ph_lo, hi = p.ph_hi;
    volatile LAS unsigned* MISC = (volatile LAS unsigned*)(lds + 131072);
    if (tid < 32) MISC[tid] = 0u;
    __syncthreads();
    XcdBarrier bar = xcd_barrier_post((unsigned*)ws, MISC + 8);
    if (lo < 0) grid.sync();
#define IN(k) (lo <= (k) && (k) < hi)
#define REP(k) for (int rep_ = 0; rep_ < (((PROBE_REP >> (k)) & 1u) ? 2 : 1); ++rep_, (((PROBE_REP >> (k)) & 1u) && rep_ < 2 ? xcd_barrier(bar) : (void)0))
#define SEAM(k) do { if (IN(k) && IN((k) + 1)) xcd_barrier(bar); } while (0)
    REP(0) if (IN(0)) p0_prologue(p, lds, tid);
    SEAM(0);
    REP(1) if (IN(1)) {
        pg8::Gemm g{(const pg8::bf16_t*)(ws + WS_XB), (const pg8::bf16_t*)(ws + WS_WIN), MROWS, ZW, 1024}; pg8::StaticOrder S; S.init(MROWS, ZW, (int)gridDim.x, (int)blockIdx.x, 1024);
        pg8::EpiStoreBf16 E{(pg8::bf16_t*)(ws + WS_Z), ZW};
        pg8::gemm_phase<pg8::EpiStoreBf16, pg8::StaticOrder, true, true>(lds, g, S, E);
    }
    SEAM(1);
    REP(2) if (IN(2)) {
        for (int u = blockIdx.x; u < NU_P2; u += gridDim.x) {
            int r = u; int tid = threadIdx.x; asm volatile("" : "+v"(tid));
            if (r < NU_MA) { unit_mlstm_a<false>(p, lds, tid, r / 132, (r / 4) % 33, r & 3); continue; } r -= NU_MA;
            if (r < NU_AP) { unit_attn_prompt(p, lds, tid, r >> 8, 1 + ((r >> 3) & 31), r & 7); continue; } r -= NU_AP;
            if (r < NU_MS) { unit_mlstm_a<true>(p, lds, tid, r >> 2, 0, r & 3); continue; } r -= NU_MS;
            unit_attn_sample(p, lds, tid, r);
        }
        p2_copies(p, tid);
    }
    SEAM(2);
    REP(3) if (IN(3)) p3_scan(p, tid);
    SEAM(3);
    REP(4) if (IN(4)) { for (int u = blockIdx.x; u < 768; u += gridDim.x) { int tid2 = threadIdx.x; asm volatile("" : "+v"(tid2));
            if (u < 512) unit_mlstm_b(p, lds, tid2, u >> 7, 1 + ((u >> 2) & 31), u & 3); else unit_mlstm_sample(p, lds, tid2, (u - 512) >> 2, u & 3); } }
    SEAM(4);
    REP(5) if (IN(5)) {
        pg8::Gemm g{(const pg8::bf16_t*)(ws + WS_Y), (const pg8::bf16_t*)(ws + WS_WOUT), MMAIN, 1024, 1024}; pg8::TailOrder<4> S; S.init(1024, (int)gridDim.x, (int)blockIdx.x, 1024);
        typedef pg8::EpiResSlab<false, 4, 256, (long)(WS_SLABB / 4), (long)(WS_SLABB / 4)> Epi5; Epi5 E{(const void*)p.in[I_XP], (pg8::bf16_t*)(ws + WS_T1), (float*)ws};
        pg8::gemm_phase<Epi5, pg8::TailOrder<4>, true, true, true>(lds, g, S, E);
    }
    SEAM(5);
    if (IN(6)) ln_rows((const bf16*)(ws + WS_T1), nullptr, (bf16*)(ws + WS_X1B), p.in[I_LN1G], p.in[I_LN1B], p.in[I_XS], (float*)(ws + WS_X1S), (const float*)(ws + WS_SLABB), 4, nullptr, 0, tid);
    SEAM(6);
    REP(7) if (IN(7)) {
        pg8::Gemm g{(const pg8::bf16_t*)(ws + WS_X1B), (const pg8::bf16_t*)(ws + WS_WGU), MMAIN, 2 * DFF, 1024}; pg8::StaticOrder S; S.init(MMAIN, 2 * DFF, (int)gridDim.x, (int)blockIdx.x, 1024);
        pg8::EpiSwiGLU E{(pg8::bf16_t*)(ws + WS_H), DFF};
        pg8::gemm_phase<pg8::EpiSwiGLU, pg8::StaticOrder, true, true>(lds, g, S, E);
    }
    SEAM(7);
    REP(8) if (IN(8)) {
        pg8::Gemm g{(const pg8::bf16_t*)(ws + WS_H), (const pg8::bf16_t*)(ws + WS_WDN), MMAIN, 1024, DFF}; pg8::TailOrder<11> S; S.init(1024, (int)gridDim.x, (int)blockIdx.x, DFF);
        typedef pg8::EpiResSlab<true, 8, 256, (long)(WS_SLABA / 4), (long)(WS_SLABB / 4)> Epi8; Epi8 E{(const void*)(ws + WS_X1B), (pg8::bf16_t*)(ws + WS_T2B), (float*)ws};
        pg8::gemm_phase<Epi8, pg8::TailOrder<11>, true, true, true>(lds, g, S, E);
    }
    SEAM(8);
    if (IN(9)) ln_rows((const bf16*)(ws + WS_T2B), p.out, nullptr, p.in[I_LN2G], p.in[I_LN2B], (const float*)(ws + WS_X1S), p.out + (size_t)R_SAMPLE * 1024, (const float*)(ws + WS_SLABA), 8, (const float*)(ws + WS_SLABB), 3, tid);
    for (int i = 0; i < PROBE_SYNCS; ++i) xcd_barrier(bar);
#undef IN
#undef SEAM
}

#ifndef MK_MULTI
#define MK_MULTI 0
#endif
extern "C" void kernel_launch(void* const* d_in, const int* in_sizes, int n_in, void* d_out, int out_size, void* d_ws, size_t ws_size, hipStream_t stream) {
    static int grid = 0;
    if (grid == 0) {
        if (n_in != 27 || out_size != (int)O_END || ws_size < WS_END) { fprintf(stderr, "kernel_launch: unexpected sizes n_in %d out %d ws %zu\n", n_in, out_size, ws_size); grid = -1; return; }
        int dev = 0, cus = 0, per_cu = 0;
        if (hipGetDevice(&dev) != hipSuccess || hipDeviceGetAttribute(&cus, hipDeviceAttributeMultiprocessorCount, dev) != hipSuccess) { grid = -1; return; }
        if (hipFuncSetAttribute((const void*)hymba_fwd, hipFuncAttributeMaxDynamicSharedMemorySize, LDS_BYTES) != hipSuccess) { fprintf(stderr, "kernel_launch: hipFuncSetAttribute failed\n"); grid = -1; return; }
        if (hipOccupancyMaxActiveBlocksPerMultiprocessor(&per_cu, (const void*)hymba_fwd, NTHR, LDS_BYTES) != hipSuccess || per_cu < 1) { fprintf(stderr, "kernel_launch: occupancy query says %d blocks per CU\n", per_cu); (void)hipGetLastError(); grid = -1; return; }
        grid = cus;
    }
    if (grid < 0) return;
    if (hipMemsetAsync(d_ws, 0, 16384, stream) != hipSuccess) { fprintf(stderr, "kernel_launch: memset failed\n"); return; }
    Params a{};
    for (int i = 0; i < 27; ++i) a.in[i] = (const float*)d_in[i];
    a.out = (float*)d_out; a.ws = (unsigned char*)d_ws;
#if MK_MULTI
    for (int k = 0; k < 10; ++k) { a.ph_lo = k; a.ph_hi = k + 1; hipLaunchKernelGGL(hymba_fwd, dim3(grid), dim3(NTHR), LDS_BYTES, stream, a); }
#else
    a.ph_lo = 0; a.ph_hi = 10;
    void* args[] = {&a};
    hipError_t e = hipLaunchCooperativeKernel((const void*)hymba_fwd, dim3(grid), dim3(NTHR), args, LDS_BYTES, stream);
    if (e != hipSuccess) fprintf(stderr, "cooperative launch failed: %s (grid %d)\n", hipGetErrorString(e), grid);
#endif
}
```

```cpp
#include <hip/hip_runtime.h>
#include <hip/hip_cooperative_groups.h>
#include <cstdio>
#include <cstdint>
namespace cg = cooperative_groups;
namespace pg8 {
#define PG8_LAS __attribute__((address_space(3)))
typedef unsigned short bf16_t;
typedef short bf16x8 __attribute__((ext_vector_type(8)));
typedef float f32x4 __attribute__((ext_vector_type(4)));
typedef unsigned u32x4 __attribute__((ext_vector_type(4)));
constexpr int BM = 256, BK = 64, HALF = 128, HTB = HALF * BK * 2  , STAGE_BYTES = 8 * HTB, NXCD = 8, WGM = 8;

__host__ __device__ __forceinline__ int lds_byte(int r, int c) { const int st = (r >> 4) * 2 + (c >> 5), rr = r & 15, cc = c & 31, ob = rr * 64 + cc * 2; return st * 1024 + (ob ^ (((ob >> 9) & 1) << 5)); }
__host__ __device__ __forceinline__ void stage_rc(int b, int& R, int& C) { const int st = b / 1024, sb = b % 1024, swz = sb ^ (((sb >> 9) & 1) << 5); R = (st >> 1) * 16 + swz / 64; C = (st & 1) * 32 + (swz % 64) / 2; }
__host__ __device__ __forceinline__ int perm32(int rho) { const int n = rho >> 4, i = rho & 15; return 8 * (i >> 2) + 4 * n + (i & 3); }

struct Unit { int pm, pn, koff, nt; };
struct Gemm { const bf16_t* A; const bf16_t* Bt; int M, N, K; };

struct StaticOrder {
    int nM, nN, nwg, G, c, ntf;
    __host__ __device__ void init(int M, int N, int G_, int c_, int K_ = 1024) { nM = M / BM; nN = N / BM; nwg = nM * nN; G = G_; c = c_; ntf = K_ / BK; }
    __host__ __device__ bool next(int i, Unit& u) const {
        const long L = (long)i * G + c; if (L >= nwg) return false;
        map((int)L, u); return true;
    }
    __host__ __device__ void map(int wgid, Unit& u) const {
        { const int q = nwg / NXCD, r = nwg % NXCD, xcd = wgid % NXCD, off = wgid / NXCD; wgid = (xcd < r ? xcd * (q + 1) : r * (q + 1) + (xcd - r) * q) + off; }
        const int nig = WGM * nN, gid = wgid / nig, fm = gid * WGM, gsz = (nM - fm) < WGM ? (nM - fm) : WGM;
        u.pm = fm + ((wgid % nig) % gsz); u.pn = (wgid % nig) / gsz; u.koff = 0; u.nt = ntf;
    }
    __device__ __forceinline__ void a_ready(const Unit&) const {}
    __device__ __forceinline__ void done(const Unit&) const {}
};

__device__ __forceinline__ unsigned cvt_pk_bf16(float lo, float hi) { unsigned r; asm volatile("v_cvt_pk_bf16_f32 %0, %1, %2" : "=v"(r) : "v"(lo), "v"(hi)); return r; }
typedef float f32x2 __attribute__((ext_vector_type(2)));
template <int S> struct TailOrder {
    StaticOrder so; int ntf;
    __host__ __device__ void init(int N, int G_, int c_, int K_) { so.init(16384, N, G_, c_, K_); ntf = K_ / BK; }
    __host__ __device__ bool next(int i, Unit& u) const {
        const long L = (long)i * so.G + so.c;
        if (L >= so.nwg + 16 * S) return false;
        const bool tail = L >= so.nwg;
        Unit a; so.map(tail ? 0 : (int)L, a);
        const int q = tail ? (int)(L - so.nwg) : 0, tile = q / S, sp = q - tile * S;
        u.pm = tail ? 64 + (tile >> 2) : a.pm; u.pn = tail ? (tile & 3) : a.pn; u.nt = tail ? ntf / S : ntf; u.koff = tail ? sp * (ntf / S) * BK : 0; return true;
    }
    __device__ __forceinline__ void a_ready(const Unit&) const {}
    __device__ __forceinline__ void done(const Unit&) const {}
};
struct EpiStoreBf16 {
    static constexpr bool PERM = true, AFTER_DRAIN = false;
    bf16_t* O; int ldc;
    __device__ __forceinline__ void operator()(const f32x4 (&acc)[2][2][4][2], const Unit& u, int wr, int wc, int fr, int fq) const {
        const int row0 = u.pm * BM + wr * 64 + fr, col0 = u.pn * BM + wc * 32 + 8 * fq;
#pragma unroll
        for (int ai = 0; ai < 2; ++ai)
#pragma unroll
            for (int m = 0; m < 4; ++m) { bf16_t* rowp = O + (size_t)(row0 + ai * HALF + m * 16) * ldc + col0;
#pragma unroll
                for (int bj = 0; bj < 2; ++bj) { const f32x4 v0 = acc[ai][bj][m][0], v1 = acc[ai][bj][m][1];
                    u32x4 w; w.x = cvt_pk_bf16(v0[0], v0[1]); w.y = cvt_pk_bf16(v0[2], v0[3]); w.z = cvt_pk_bf16(v1[0], v1[1]); w.w = cvt_pk_bf16(v1[2], v1[3]);
                    *(u32x4*)(rowp + bj * HALF) = w; } }
    }
};
__device__ __forceinline__ float silu_f(float g) { return g * __builtin_amdgcn_rcpf(1.0f + __expf(-g)); }
struct EpiSwiGLU {
    static constexpr bool PERM = true, AFTER_DRAIN = false;
    bf16_t* H; int ldh;
    __device__ __forceinline__ void operator()(const f32x4 (&acc)[2][2][4][2], const Unit& u, int wr, int wc, int fr, int fq) const {
        const int row0 = u.pm * BM + wr * 64 + fr, col0 = u.pn * HALF + wc * 32 + 8 * fq;
#pragma unroll
        for (int ai = 0; ai < 2; ++ai)
#pragma unroll
            for (int m = 0; m < 4; ++m) { bf16_t* rowp = H + (size_t)(row0 + ai * HALF + m * 16) * ldh + col0;
                const f32x4 g0 = acc[ai][0][m][0], g1 = acc[ai][0][m][1], u0 = acc[ai][1][m][0], u1 = acc[ai][1][m][1];
                u32x4 w; w.x = cvt_pk_bf16(silu_f(g0[0]) * u0[0], silu_f(g0[1]) * u0[1]); w.y = cvt_pk_bf16(silu_f(g0[2]) * u0[2], silu_f(g0[3]) * u0[3]);
                w.z = cvt_pk_bf16(silu_f(g1[0]) * u1[0], silu_f(g1[1]) * u1[1]); w.w = cvt_pk_bf16(silu_f(g1[2]) * u1[2], silu_f(g1[3]) * u1[3]);
                *(u32x4*)rowp = w; }
    }
};
template <bool BASE_BF16, int NS0, int KPER, long OFF0, long OFF1>
struct EpiResSlab {
    static constexpr bool PERM = false, AFTER_DRAIN = false;
    const void* base; bf16_t* out; float* wsf;
    __device__ __forceinline__ void operator()(const f32x4 (&acc)[2][2][4][2], const Unit& u, int wr, int wc, int fr, int fq) const {
        typedef unsigned u32x2v __attribute__((ext_vector_type(2)));
        constexpr int ld = 1024; constexpr float alpha = 1.189207115002721f;
        const int col0 = u.pn * BM + wc * 32 + 4 * fq;
        if (u.pm < 64) {
            const size_t t0 = (size_t)(u.pm * BM) * ld;
#pragma unroll
            for (int ai = 0; ai < 2; ++ai)
#pragma unroll
                for (int m = 0; m < 4; ++m) { const int r = ai * HALF + wr * 64 + m * 16 + fr;
#pragma unroll
                    for (int bj = 0; bj < 2; ++bj)
#pragma unroll
                        for (int n = 0; n < 2; ++n) { const size_t o = t0 + (size_t)r * ld + col0 + bj * HALF + n * 16; f32x4 bv;
                            if (BASE_BF16) { const u32x2v w = *(const u32x2v*)((const bf16_t*)base + o); bv = (f32x4){__uint_as_float(w.x << 16), __uint_as_float(w.x & 0xffff0000u), __uint_as_float(w.y << 16), __uint_as_float(w.y & 0xffff0000u)}; }
                            else bv = *(const f32x4*)((const float*)base + o);
                            const f32x4 t = bv * alpha + acc[ai][bj][m][n];
                            u32x2v ow; ow.x = cvt_pk_bf16(t[0], t[1]); ow.y = cvt_pk_bf16(t[2], t[3]); *(u32x2v*)(out + o) = ow; } }
        } else {
            const int sp = u.koff / KPER;
            float* ot = wsf + (sp < NS0 ? OFF0 + (long)sp * 1048576 : OFF1 + (long)(sp - NS0) * 1048576) + (long)((u.pm - 64) * BM) * ld;
#pragma unroll
            for (int ai = 0; ai < 2; ++ai)
#pragma unroll
                for (int m = 0; m < 4; ++m) { const int r = ai * HALF + wr * 64 + m * 16 + fr;
#pragma unroll
                    for (int bj = 0; bj < 2; ++bj)
#pragma unroll
                        for (int n = 0; n < 2; ++n) *(f32x4*)(ot + (size_t)r * ld + col0 + bj * HALF + n * 16) = acc[ai][bj][m][n]; }
        }
    }
};
template <class Epi, class Sched, bool ALIGN_EPI = false, bool SP2 = false, bool VARK = false>
__device__ __forceinline__ void gemm_phase(PG8_LAS unsigned char* lds, const Gemm g, const Sched S, const Epi E) {
    int tid_ = threadIdx.x; asm volatile("" : "+v"(tid_));
    const int tid = tid_, wid = __builtin_amdgcn_readfirstlane(tid >> 6), lane = tid & 63, wr = wid >> 2, wc = wid & 3, fr = lane & 15, fq = lane >> 4;
    const int K = g.K;
    unsigned voffA[2], voffB[2];
#pragma unroll
    for (int i = 0; i < 2; ++i) { int R, C; stage_rc(tid * 16 + i * 8192, R, C); const int Rb = Epi::PERM ? ((R & ~31) + perm32(R & 31)) : R;
        voffA[i] = (unsigned)(R * K + C) * 2u; voffB[i] = (unsigned)(Rb * K + C) * 2u; }
    const size_t kstep = (size_t)(BK * 2);
    const size_t hstep = (size_t)HALF * K * 2;
    const size_t tstep = 2 * hstep;
    const unsigned ldsw = (unsigned)wid * 1024u;
    const int aoff = lds_byte(wr * 64 + fr, fq * 8), boff = lds_byte(wc * 32 + fr, fq * 8);
#define PG8_SA(b, h) (((b) * 2 + (h)) * HTB)
#define PG8_SB(b, h) ((4 + (b) * 2 + (h)) * HTB)
#define PG8_STAGE(bufoff, gbase, voff) do { _Pragma("unroll") for (int _i = 0; _i < 2; ++_i) \
        __builtin_amdgcn_global_load_lds((const unsigned*)((const char*)(gbase) + (voff)[_i]), (PG8_LAS unsigned*)(lds + (bufoff) + ldsw + _i * 8192), 16, 0, 0); } while (0)
#define PG8_LDA(dst, b, h) do { _Pragma("unroll") for (int m = 0; m < 4; ++m) _Pragma("unroll") for (int k = 0; k < 2; ++k) dst[m][k] = *(const PG8_LAS bf16x8*)(lds + PG8_SA(b, h) + aoff + m * 2048 + k * 1024); } while (0)
#define PG8_LDB(dst, b, h) do { _Pragma("unroll") for (int n = 0; n < 2; ++n) _Pragma("unroll") for (int k = 0; k < 2; ++k) dst[n][k] = *(const PG8_LAS bf16x8*)(lds + PG8_SB(b, h) + boff + n * 2048 + k * 1024); } while (0)
#define PG8_MMA(ai, bj, At, Bt) do { __builtin_amdgcn_s_setprio(1); _Pragma("unroll") for (int m = 0; m < 4; ++m) _Pragma("unroll") for (int n = 0; n < 2; ++n) _Pragma("unroll") for (int k = 0; k < 2; ++k) \
        acc[ai][bj][m][n] = __builtin_amdgcn_mfma_f32_16x16x32_bf16(Bt[n][k], At[m][k], acc[ai][bj][m][n], 0, 0, 0); __builtin_amdgcn_s_setprio(0); } while (0)
#define PG8_WAIT_V(n) asm volatile("s_waitcnt vmcnt(" #n ")" ::: "memory")
#define PG8_WAIT_L(n) asm volatile("s_waitcnt lgkmcnt(" #n ")" ::: "memory")
#define PG8_BAR __builtin_amdgcn_s_barrier()
#define PG8_SCHED __builtin_amdgcn_sched_barrier(0)
    Unit cur, nxt; int ui = 0;
    if (!S.next(0, cur)) return;
    f32x4 acc[2][2][4][2];
#pragma unroll
    for (int a = 0; a < 2; ++a)
#pragma unroll
        for (int b = 0; b < 2; ++b)
#pragma unroll
            for (int m = 0; m < 4; ++m)
#pragma unroll
                for (int n = 0; n < 2; ++n) acc[a][b][m][n] = (f32x4){0.f, 0.f, 0.f, 0.f};
    bf16x8 At[4][2], B0[2][2], B1[2][2];
    const char* cA = (const char*)g.A + (size_t)cur.pm * tstep + (VARK ? (size_t)cur.koff * 2 : 0); const char* cB = (const char*)g.Bt + (size_t)cur.pn * tstep + (VARK ? (size_t)cur.koff * 2 : 0);
    S.a_ready(cur);
    if constexpr (SP2) {
        PG8_STAGE(PG8_SB(0, 0), cB, voffB); PG8_STAGE(PG8_SB(0, 1), cB + hstep, voffB); PG8_STAGE(PG8_SA(0, 0), cA, voffA); PG8_STAGE(PG8_SA(0, 1), cA + hstep, voffA);
        if (wr == 1) PG8_BAR;
        PG8_WAIT_V(2); PG8_BAR;
        PG8_STAGE(PG8_SB(1, 0), cB + kstep, voffB); PG8_STAGE(PG8_SA(1, 0), cA + kstep, voffA); PG8_STAGE(PG8_SB(1, 1), cB + hstep + kstep, voffB);
        PG8_WAIT_V(6); PG8_BAR;
    } else {
        PG8_STAGE(PG8_SB(0, 0), cB, voffB); PG8_STAGE(PG8_SA(0, 0), cA, voffA); PG8_STAGE(PG8_SB(0, 1), cB + hstep, voffB); PG8_STAGE(PG8_SA(0, 1), cA + hstep, voffA);
        if (wr == 1) PG8_BAR;
        PG8_WAIT_V(4); PG8_BAR;
        PG8_STAGE(PG8_SB(1, 0), cB + kstep, voffB); PG8_STAGE(PG8_SA(1, 0), cA + kstep, voffA); PG8_STAGE(PG8_SB(1, 1), cB + hstep + kstep, voffB);
        PG8_WAIT_V(6); PG8_BAR;
    }
    for (;;) {
        const bool has_next = S.next(ui + 1, nxt);
        const char* nA = has_next ? (const char*)g.A + (size_t)nxt.pm * tstep + (VARK ? (size_t)nxt.koff * 2 : 0) : cA; const char* nB = has_next ? (const char*)g.Bt + (size_t)nxt.pn * tstep + (VARK ? (size_t)nxt.koff * 2 : 0) : cB;
        const int nt = VARK ? cur.nt : K / BK;
        for (int t = 0; t < nt; t += 2) {
            const bool last = (t == nt - 2);
            const char* a1 = cA + (size_t)(t + 1) * kstep;
            const char* a2 = last ? nA : cA + (size_t)(t + 2) * kstep; const char* b2 = last ? nB : cB + (size_t)(t + 2) * kstep;
            const char* a3 = a2 + kstep; const char* b3 = b2 + kstep;
            if (last && has_next) S.a_ready(nxt);
            if constexpr (SP2) {
            PG8_LDB(B0, 0, 0); PG8_LDB(B1, 0, 1); PG8_SCHED; PG8_LDA(At, 0, 0); PG8_STAGE(PG8_SA(1, 1), a1 + hstep, voffA);
            PG8_WAIT_V(8); PG8_WAIT_L(0); PG8_BAR; PG8_MMA(0, 0, At, B0); PG8_MMA(0, 1, At, B1); PG8_BAR; PG8_SCHED;
            PG8_LDA(At, 0, 1); PG8_STAGE(PG8_SB(0, 0), b2, voffB); PG8_STAGE(PG8_SB(0, 1), b2 + hstep, voffB); PG8_STAGE(PG8_SA(0, 0), a2, voffA);
            PG8_WAIT_V(8); PG8_WAIT_L(0); PG8_BAR; PG8_MMA(1, 0, At, B0); PG8_MMA(1, 1, At, B1); PG8_BAR; PG8_SCHED;
            PG8_LDB(B0, 1, 0); PG8_LDB(B1, 1, 1); PG8_SCHED; PG8_LDA(At, 1, 0); PG8_STAGE(PG8_SA(0, 1), a2 + hstep, voffA);
            PG8_WAIT_V(8); PG8_WAIT_L(0); PG8_BAR; PG8_MMA(0, 0, At, B0); PG8_MMA(0, 1, At, B1); PG8_BAR; PG8_SCHED;
            PG8_LDA(At, 1, 1); PG8_STAGE(PG8_SB(1, 0), b3, voffB); PG8_STAGE(PG8_SB(1, 1), b3 + hstep, voffB); PG8_STAGE(PG8_SA(1, 0), a3, voffA);
            PG8_WAIT_V(8); PG8_WAIT_L(0); PG8_BAR; PG8_MMA(1, 0, At, B0); PG8_MMA(1, 1, At, B1); PG8_BAR; PG8_SCHED;
            } else {
            PG8_LDB(B0, 0, 0); PG8_SCHED; PG8_LDA(At, 0, 0); PG8_STAGE(PG8_SA(1, 1), a1 + hstep, voffA);
            PG8_WAIT_L(8); PG8_BAR; PG8_WAIT_L(0); PG8_MMA(0, 0, At, B0); PG8_BAR; PG8_SCHED;
            PG8_LDB(B1, 0, 1); PG8_STAGE(PG8_SB(0, 0), b2, voffB);
            PG8_BAR; PG8_WAIT_L(0); PG8_MMA(0, 1, At, B1); PG8_BAR;
            PG8_LDA(At, 0, 1); PG8_STAGE(PG8_SA(0, 0), a2, voffA);
            PG8_BAR; PG8_WAIT_L(0); PG8_MMA(1, 0, At, B0); PG8_BAR; PG8_SCHED;
            PG8_STAGE(PG8_SB(0, 1), b2 + hstep, voffB);
            PG8_WAIT_V(6); PG8_BAR; PG8_MMA(1, 1, At, B1); PG8_BAR;
            PG8_LDB(B0, 1, 0); PG8_SCHED; PG8_LDA(At, 1, 0); PG8_STAGE(PG8_SA(0, 1), a2 + hstep, voffA);
            PG8_WAIT_L(8); PG8_BAR; PG8_WAIT_L(0); PG8_MMA(0, 0, At, B0); PG8_BAR; PG8_SCHED;
            PG8_LDB(B1, 1, 1); PG8_STAGE(PG8_SB(1, 0), b3, voffB);
            PG8_BAR; PG8_WAIT_L(0); PG8_MMA(0, 1, At, B1); PG8_BAR;
            PG8_LDA(At, 1, 1); PG8_STAGE(PG8_SA(1, 0), a3, voffA);
            PG8_BAR; PG8_WAIT_L(0); PG8_MMA(1, 0, At, B0); PG8_BAR; PG8_SCHED;
            PG8_STAGE(PG8_SB(1, 1), b3 + hstep, voffB);
            PG8_WAIT_V(6); PG8_BAR; PG8_MMA(1, 1, At, B1); PG8_BAR;
            }
        }
        if constexpr (ALIGN_EPI) { if (wr == 0) PG8_BAR; }
        if constexpr (!Epi::AFTER_DRAIN) { E(acc, cur, wr, wc, fr, fq); S.done(cur); }
        if (!has_next) break;
#pragma unroll
        for (int a = 0; a < 2; ++a)
#pragma unroll
            for (int b = 0; b < 2; ++b)
#pragma unroll
                for (int m = 0; m < 4; ++m)
#pragma unroll
                    for (int n = 0; n < 2; ++n) acc[a][b][m][n] = (f32x4){0.f, 0.f, 0.f, 0.f};
        cur = nxt; cA = nA; cB = nB; ++ui;
        if constexpr (ALIGN_EPI) { if (wr == 1) PG8_BAR; }
    }
    PG8_WAIT_V(0);
    if constexpr (!ALIGN_EPI) { if (wr == 0) PG8_BAR; }
    PG8_BAR;
    if constexpr (Epi::AFTER_DRAIN) { E.fused(acc, cur, wr, wc, fr, fq, lds, wid, lane); S.done(cur); }
#undef PG8_SA
#undef PG8_SB
#undef PG8_STAGE
#undef PG8_LDA
#undef PG8_LDB
#undef PG8_MMA
#undef PG8_WAIT_V
#undef PG8_WAIT_L
#undef PG8_BAR
#undef PG8_SCHED
}
}

#define LAS __attribute__((address_space(3)))
typedef unsigned short bf16;
typedef unsigned v4u __attribute__((ext_vector_type(4)));
typedef unsigned v2u __attribute__((ext_vector_type(2)));
typedef float f32x4 __attribute__((ext_vector_type(4)));
typedef float f32x2 __attribute__((ext_vector_type(2)));
typedef short bf16x8 __attribute__((ext_vector_type(8)));
#define MFMA16(a, b, c) __builtin_amdgcn_mfma_f32_16x16x32_bf16((a), (b), (c), 0, 0, 0)
#define LDS_WAIT() asm volatile("s_waitcnt lgkmcnt(0)" ::: "memory")

constexpr int NTHR = 512;
constexpr int MROWS = 17920, MMAIN = 17408, R_SAMPLE = 16384, R_BLK0 = 17408;
constexpr int ZW = 2304, INW = 2312, DFF = 2816;
constexpr int ZC_K = 512, ZC_V = 640, ZC_C = 768, ZC_VM = 1280, ZC_O = 1792;
constexpr float ALPHA = 1.189207115002721f, LN_EPS = 1e-5f, KSCALE = 0.08838834764831845f;
enum { I_XP = 0, I_XS, I_CK, I_CV, I_SCONV, I_SC, I_SN, I_SM, I_META, I_WIN, I_WCONV, I_BCONV, I_WMQ, I_WMK, I_BI, I_BF, I_SINK, I_GATT, I_GML, I_WOUT, I_LN1G, I_LN1B, I_WGATE, I_WUP, I_WDOWN, I_LN2G, I_LN2B };
constexpr size_t O_YP = 0, O_YS = 16777216, O_PK = O_YS + 1048576, O_PV = O_PK + 65536, O_PCONV = O_PV + 65536, O_PC = O_PCONV + 6144, O_PN = O_PC + 262144, O_PM = O_PN + 2048,
                 O_SK = O_PM + 16, O_SV = O_SK + 2097152, O_SCONV = O_SV + 2097152, O_SC = O_SCONV + 196608, O_SN = O_SC + 8388608, O_SM = O_SN + 65536, O_END = O_SM + 512;
static_assert(O_END == 31072784, "output size");
constexpr size_t MiB = 1u << 20;
constexpr size_t WS_WIN = 1 * MiB, WS_WOUT = 6 * MiB, WS_WGU = 8 * MiB, WS_WDN = 19 * MiB, WS_WMQ = 25 * MiB, WS_WMK = 25 * MiB + 131072;
constexpr size_t WS_GATES = 26 * MiB, WS_SCAL = 27 * MiB, WS_CSUM = 27 * MiB + 32768, WS_DN = 27 * MiB + 65536, WS_NS = 27 * MiB + 524288;
constexpr size_t WS_XB = 29 * MiB, WS_DC = 29 * MiB, WS_Z = 64 * MiB, WS_QM = 143 * MiB, WS_KM = 143 * MiB + (size_t)MROWS * 512 * 2, WS_CS = 178 * MiB, WS_Y = 195 * MiB;
constexpr size_t WS_T1 = 29 * MiB, WS_X1B = 97 * MiB, WS_H = 131 * MiB, WS_X1S = 229 * MiB  , WS_SLABB = 233 * MiB  , WS_SLABA = 29 * MiB  , WS_T2B = 61 * MiB  , WS_TOKG = 249 * MiB  , WS_END = 251 * MiB;
static_assert(WS_KM + (size_t)MROWS * 512 * 2 <= WS_CS && WS_Z + (size_t)MROWS * ZW * 2 <= WS_QM && WS_H + (size_t)MMAIN * DFF * 2 <= WS_END && WS_T1 + (size_t)MMAIN * 4096 <= WS_X1B, "ws map");
constexpr int LDS_BYTES = 132096;

struct Params { const float* in[27]; float* out; unsigned char* ws; int ph_lo, ph_hi; };

__device__ __forceinline__ int row_of(int b, int pos) { return pos >= 128 ? b * 4096 + (pos - 128) : R_BLK0 + b * 128 + pos; }
__device__ __forceinline__ float bflo(unsigned w) { return __uint_as_float(w << 16); }
__device__ __forceinline__ float bfhi(unsigned w) { return __uint_as_float(w & 0xffff0000u); }
__device__ __forceinline__ float bf2f(unsigned short h) { return __uint_as_float(((unsigned)h) << 16); }
__device__ __forceinline__ unsigned pk2(float lo, float hi) { return pg8::cvt_pk_bf16(lo, hi); }
__device__ __forceinline__ unsigned short f2bf1(float x) { return (unsigned short)(pg8::cvt_pk_bf16(x, 0.f) & 0xffffu); }
__device__ __forceinline__ float wave_sum(float v) {
#pragma unroll
    for (int o = 1; o < 64; o <<= 1) v += __shfl_xor(v, o);
    return v;
}
__device__ __forceinline__ float quad_sum(float v) { v += __shfl_xor(v, 16); v += __shfl_xor(v, 32); return v; }
__device__ __forceinline__ float quad_max(float v) { v = fmaxf(v, __shfl_xor(v, 16)); v = fmaxf(v, __shfl_xor(v, 32)); return v; }
__device__ __forceinline__ float sigmoid_f(float x) { return 1.0f / (1.0f + __expf(-x)); }
__device__ __forceinline__ float logsig_f(float x) { return fminf(x, 0.f) - __logf(1.0f + __expf(-fabsf(x))); }
__device__ __forceinline__ void unpack8(const v4u r, float (&x)[8]) { x[0] = bflo(r.x); x[1] = bfhi(r.x); x[2] = bflo(r.y); x[3] = bfhi(r.y); x[4] = bflo(r.z); x[5] = bfhi(r.z); x[6] = bflo(r.w); x[7] = bfhi(r.w); }
__device__ __forceinline__ unsigned elem16(const v4u r, int e) { const unsigned w = (e >> 1) == 0 ? r.x : (e >> 1) == 1 ? r.y : (e >> 1) == 2 ? r.z : r.w; return (e & 1) ? (w >> 16) : (w & 0xffffu); }
__device__ __forceinline__ void store_vt(LAS bf16* VT, int stride, int c0, int s0, const v4u (&raw)[4]) {
#pragma unroll
    for (int e = 0; e < 8; ++e) { v2u o; o.x = elem16(raw[0], e) | (elem16(raw[1], e) << 16); o.y = elem16(raw[2], e) | (elem16(raw[3], e) << 16);
        *(LAS v2u*)(VT + (c0 + e) * stride + s0) = o; }
}
__device__ __forceinline__ bf16x8 mk8(const v2u lo, const v2u hi) { v4u t; t.x = lo.x; t.y = lo.y; t.z = hi.x; t.w = hi.y; return __builtin_bit_cast(bf16x8, t); }
__device__ __forceinline__ bf16x8 pack8(const float (&p)[8]) { v4u t; t.x = pk2(p[0], p[1]); t.y = pk2(p[2], p[3]); t.z = pk2(p[4], p[5]); t.w = pk2(p[6], p[7]); return __builtin_bit_cast(bf16x8, t); }

__device__ __forceinline__ void tr_item(const float* W, int ldw, int k0, int n0, bf16* WT, int drow0, int ldk, LAS float* scr, int lane) {
#pragma unroll
    for (int i = 0; i < 8; ++i) { const int kk = 8 * i + (lane >> 3), c4 = lane & 7; const f32x4 v = *(const f32x4*)(W + (size_t)(k0 + kk) * ldw + n0 + 4 * c4);
        LAS float* d = scr + kk * 33 + 4 * c4; d[0] = v[0]; d[1] = v[1]; d[2] = v[2]; d[3] = v[3]; }
    LDS_WAIT();
    const int c = lane & 7;
#pragma unroll
    for (int j = 0; j < 4; ++j) { const int n = (lane >> 3) + 8 * j; const LAS float* s = scr + (8 * c) * 33 + n;
        v4u o; o.x = pk2(s[0 * 33], s[1 * 33]); o.y = pk2(s[2 * 33], s[3 * 33]); o.z = pk2(s[4 * 33], s[5 * 33]); o.w = pk2(s[6 * 33], s[7 * 33]);
        *(v4u*)(WT + (size_t)(drow0 + n) * ldk + k0 + 8 * c) = o; }
    LDS_WAIT();
}
__device__ __forceinline__ void scan_vals(const float (&li)[2], const float (&lf)[2], int lane, float (&bb)[2], float (&aa)[2], float (&mx)[2]) {
    const float s = lf[0] + lf[1]; float sc = s;
#pragma unroll
    for (int o = 1; o < 64; o <<= 1) { const float n = __shfl_up(sc, o); if (lane >= o) sc += n; }
    const float excl = sc - s;
    bb[0] = excl + lf[0]; bb[1] = bb[0] + lf[1];
    aa[0] = li[0] - bb[0]; aa[1] = li[1] - bb[1];
    float pc = fmaxf(aa[0], aa[1]);
#pragma unroll
    for (int o = 1; o < 64; o <<= 1) { const float n = __shfl_up(pc, o); if (lane >= o) pc = fmaxf(pc, n); }
    float exm = __shfl_up(pc, 1); if (lane == 0) exm = -INFINITY;
    mx[0] = fmaxf(exm, aa[0]); mx[1] = fmaxf(mx[0], aa[1]);
}
constexpr int P0_I_IN = 16 * 72, P0_I_OUT = 16 * 32, P0_I_G = 16 * 88, P0_I_D = 44 * 32, P0_I_M = 32;
constexpr int P0_NIT = P0_I_IN + P0_I_OUT + 2 * P0_I_G + P0_I_D + 2 * P0_I_M;
__device__ __forceinline__ void p0_items(const Params& p, LAS unsigned char* lds, int tid, int lo, int hi, int gw, int NGW) {
    const int lane = tid & 63, wave = __builtin_amdgcn_readfirstlane(tid >> 6);
    LAS float* scr = (LAS float*)(lds + wave * 16384);
    unsigned char* ws = p.ws;
    constexpr int I_IN = P0_I_IN, I_OUT = P0_I_OUT, I_G = P0_I_G, I_D = P0_I_D, I_M = P0_I_M;
    for (int it = lo + gw; it < hi; it += NGW) {
        int r = it;
        if (r < I_IN) { const int kb = r / 72, nb = r % 72; tr_item(p.in[I_WIN], INW, 64 * kb, 32 * nb, (bf16*)(ws + WS_WIN), 32 * nb, 1024, scr, lane); continue; } r -= I_IN;
        if (r < I_OUT) { const int kb = r / 32, nb = r % 32; tr_item(p.in[I_WOUT], 1024, 64 * kb, 32 * nb, (bf16*)(ws + WS_WOUT), 32 * nb, 1024, scr, lane); continue; } r -= I_OUT;
        if (r < I_G) { const int kb = r / 88, nb = r % 88, n0 = 32 * nb; tr_item(p.in[I_WGATE], DFF, 64 * kb, n0, (bf16*)(ws + WS_WGU), (n0 >> 7) * 256 + (n0 & 127), 1024, scr, lane); continue; } r -= I_G;
        if (r < I_G) { const int kb = r / 88, nb = r % 88, n0 = 32 * nb; tr_item(p.in[I_WUP], DFF, 64 * kb, n0, (bf16*)(ws + WS_WGU), (n0 >> 7) * 256 + 128 + (n0 & 127), 1024, scr, lane); continue; } r -= I_G;
        if (r < I_D) { const int kb = r / 32, nb = r % 32; tr_item(p.in[I_WDOWN], 1024, 64 * kb, 32 * nb, (bf16*)(ws + WS_WDN), 32 * nb, DFF, scr, lane); continue; } r -= I_D;
        if (r < I_M) { const int h = r >> 3, kb = (r >> 2) & 1, nb = r & 3; tr_item(p.in[I_WMQ] + h * 16384, 128, 64 * kb, 32 * nb, (bf16*)(ws + WS_WMQ) + h * 16384, 32 * nb, 128, scr, lane); continue; } r -= I_M;
        { const int h = r >> 3, kb = (r >> 2) & 1, nb = r & 3; tr_item(p.in[I_WMK] + h * 16384, 128, 64 * kb, 32 * nb, (bf16*)(ws + WS_WMK) + h * 16384, 32 * nb, 128, scr, lane); }
    }
}
__device__ __forceinline__ void p0_load_row(const Params& p, int R, int lane, f32x4 (&v)[4]) {
    const float* src = nullptr;
    if (R < R_SAMPLE) src = p.in[I_XP] + (size_t)R * 1024;
    else if (R < R_BLK0) src = p.in[I_XS] + (size_t)(R - R_SAMPLE) * 1024;
    else { const int pp = (R - R_BLK0) & 127; if (pp >= 112) src = p.in[I_META] + (size_t)(pp - 112) * 1024; }
    if (src) {
#pragma unroll
        for (int j = 0; j < 4; ++j) v[j] = ((const f32x4*)src)[lane + 64 * j];
    } else {
#pragma unroll
        for (int j = 0; j < 4; ++j) v[j] = (f32x4){0.f, 0.f, 0.f, 0.f};
    }
}
__device__ __forceinline__ void p0_prologue(const Params& p, LAS unsigned char* lds, int tid) {
    const int lane = tid & 63, wave = __builtin_amdgcn_readfirstlane(tid >> 6);
    LAS float* scr = (LAS float*)(lds + wave * 16384);
    unsigned char* ws = p.ws;
    const int gw = (int)blockIdx.x * 8 + wave, NGW = (int)gridDim.x * 8;
    {
        f32x4 wa[4][4], wb[4][4];
        {
            LAS float* wl = (LAS float*)lds;
            for (int k = tid; k < 1024; k += NTHR) { const float* wp = p.in[I_WIN] + (size_t)k * INW + ZW; *(LAS f32x4*)(wl + k * 8) = *(const f32x4*)wp; *(LAS f32x4*)(wl + k * 8 + 4) = *(const f32x4*)(wp + 4); }
            __syncthreads();
#pragma unroll
            for (int j = 0; j < 4; ++j)
#pragma unroll
                for (int e = 0; e < 4; ++e) { const LAS float* wp = wl + (4 * lane + 256 * j + e) * 8; wa[j][e] = *(const LAS f32x4*)wp; wb[j][e] = *(const LAS f32x4*)(wp + 4); }
            __syncthreads();
        }
        bf16* Xb = (bf16*)(ws + WS_XB); float* gates = (float*)(ws + WS_GATES);
        f32x4 v[4];
        int R = gw; if (R < MROWS) p0_load_row(p, R, lane, v);
        while (R < MROWS) {
            const int Rn = R + NGW; f32x4 vn[4];
            if (Rn < MROWS) p0_load_row(p, Rn, lane, vn);
            f32x4 ga = {0.f, 0.f, 0.f, 0.f}, gb = {0.f, 0.f, 0.f, 0.f};
            unsigned long long* o8 = (unsigned long long*)(Xb + (size_t)R * 1024) + lane;
#pragma unroll
            for (int j = 0; j < 4; ++j) {
                o8[64 * j] = (unsigned long long)pk2(v[j][0], v[j][1]) | ((unsigned long long)pk2(v[j][2], v[j][3]) << 32);
#pragma unroll
                for (int e = 0; e < 4; ++e) { ga += wa[j][e] * v[j][e]; gb += wb[j][e] * v[j][e]; }
            }
#pragma unroll
            for (int e = 0; e < 4; ++e) { ga[e] = wave_sum(ga[e]); gb[e] = wave_sum(gb[e]); }
            if (lane == 0) { *(f32x4*)(gates + (size_t)R * 8) = ga; *(f32x4*)(gates + (size_t)R * 8 + 4) = gb; }
#pragma unroll
            for (int j = 0; j < 4; ++j) v[j] = vn[j];
            R = Rn;
        }
    }
    p0_items(p, lds, tid, 0, P0_I_IN, gw, NGW);
}

__device__ __forceinline__ void chunk_scan(const float* gates, const float* b_i, const float* b_f, int b, int j, int h, int lane, float (&bb)[2], float (&aa)[2], float (&mx)[2]) {
    const int R0 = row_of(b, 128 * j);
    float li[2], lf[2];
#pragma unroll
    for (int i = 0; i < 2; ++i) { const int t = 2 * lane + i, pos = 128 * j + t; const float* g = gates + (size_t)(R0 + t) * 8;
        const float ip = g[h] + b_i[h], fp = g[4 + h] + b_f[h]; const bool valid = pos >= 112;
        li[i] = valid ? ip : -INFINITY; lf[i] = valid ? logsig_f(fp) : 0.f; }
    scan_vals(li, lf, lane, bb, aa, mx);
}

template <bool SAMPLE>
__device__ __forceinline__ void unit_mlstm_a(const Params& p, LAS unsigned char* lds, int tid, int b, int j, int h) {
    const int lane = tid & 63, wave = __builtin_amdgcn_readfirstlane(tid >> 6);
    LAS bf16* CA = (LAS bf16*)lds; LAS bf16* VT = (LAS bf16*)(lds + 34816); LAS bf16* KT = (LAS bf16*)(lds + 69632);
    LAS float* wk = (LAS float*)(lds + 104448); LAS float* sB = wk + 128; LAS float* sM = sB + 64;
    unsigned char* ws = p.ws;
    const bf16* Z = (const bf16*)(ws + WS_Z); const float* gates = (const float*)(ws + WS_GATES);
    const int u = SAMPLE ? 0 : (b * 33 + j) * 4 + h, R0 = SAMPLE ? R_SAMPLE + 128 * b : row_of(b, 128 * j);
    {
        const int rg = tid >> 4, c8 = tid & 15, col = 128 * h + 8 * c8;
        float wc[4][8], bc[8];
#pragma unroll
        for (int jj = 0; jj < 4; ++jj) { const f32x4 a0 = *(const f32x4*)(p.in[I_WCONV] + jj * 512 + col), a1 = *(const f32x4*)(p.in[I_WCONV] + jj * 512 + col + 4);
            wc[jj][0] = a0[0]; wc[jj][1] = a0[1]; wc[jj][2] = a0[2]; wc[jj][3] = a0[3]; wc[jj][4] = a1[0]; wc[jj][5] = a1[1]; wc[jj][6] = a1[2]; wc[jj][7] = a1[3]; }
        { const f32x4 a0 = *(const f32x4*)(p.in[I_BCONV] + col), a1 = *(const f32x4*)(p.in[I_BCONV] + col + 4);
            bc[0] = a0[0]; bc[1] = a0[1]; bc[2] = a0[2]; bc[3] = a0[3]; bc[4] = a1[0]; bc[5] = a1[1]; bc[6] = a1[2]; bc[7] = a1[3]; }
        float x[7][8];
#pragma unroll
        for (int i = 0; i < 7; ++i) { const int lt = 4 * rg + i - 3; v4u raw = {0u, 0u, 0u, 0u};
            if (SAMPLE) {
                if (i >= 3 || (rg & 1)) { raw = *(const v4u*)(Z + (size_t)(R0 + lt) * ZW + ZC_C + col); unpack8(raw, x[i]); }
                else { const float* sp = p.in[I_SCONV] + (size_t)((16 * b + (rg >> 1)) * 3 + i) * 512 + col; const f32x4 a0 = *(const f32x4*)sp, a1 = *(const f32x4*)(sp + 4);
                    x[i][0] = a0[0]; x[i][1] = a0[1]; x[i][2] = a0[2]; x[i][3] = a0[3]; x[i][4] = a1[0]; x[i][5] = a1[1]; x[i][6] = a1[2]; x[i][7] = a1[3]; }
            } else {
                if (lt >= 0) raw = *(const v4u*)(Z + (size_t)(R0 + lt) * ZW + ZC_C + col);
                else if (j > 0) raw = *(const v4u*)(Z + (size_t)row_of(b, 128 * j + lt) * ZW + ZC_C + col);
                unpack8(raw, x[i]); } }
#pragma unroll
        for (int r = 0; r < 4; ++r) { float y[8];
#pragma unroll
            for (int e = 0; e < 8; ++e) { const float t = bc[e] + wc[0][e] * x[r][e] + wc[1][e] * x[r + 1][e] + wc[2][e] * x[r + 2][e] + wc[3][e] * x[r + 3][e]; y[e] = t * sigmoid_f(t); }
            v4u o; o.x = pk2(y[0], y[1]); o.y = pk2(y[2], y[3]); o.z = pk2(y[4], y[5]); o.w = pk2(y[6], y[7]);
            *(LAS v4u*)(CA + (4 * rg + r) * 136 + 8 * c8) = o; }
        if (!SAMPLE) { v4u raw[4];
#pragma unroll
            for (int r = 0; r < 4; ++r) raw[r] = *(const v4u*)(Z + (size_t)(R0 + 4 * rg + r) * ZW + ZC_VM + col);
            store_vt(VT, 136, 8 * c8, 4 * rg, raw); }
    }
    if (!SAMPLE && wave == 0) {
        float bb[2], aa[2], mx[2]; chunk_scan(gates, p.in[I_BI], p.in[I_BF], b, j, h, lane, bb, aa, mx);
        const float Bc = __shfl(bb[1], 63), Ml = __shfl(mx[1], 63), Mref = (Ml == -INFINITY) ? 0.f : Ml;
        wk[2 * lane] = __expf(aa[0] - Mref); wk[2 * lane + 1] = __expf(aa[1] - Mref);
        float* tg = (float*)(ws + WS_TOKG) + ((size_t)(R0 + 2 * lane) * 4 + h) * 4;
        *(f32x4*)tg = (f32x4){aa[0], bb[0], mx[0], 0.f}; *(f32x4*)(tg + 16) = (f32x4){aa[1], bb[1], mx[1], 0.f};
        if (lane == 0) *(f32x2*)((float*)(ws + WS_CSUM) + 2 * u) = (f32x2){Bc, Ml};
    }
    __syncthreads();
    const int wr = wave >> 1, wcn = wave & 1, fr = lane & 15, fq = lane >> 4;
    {
        f32x4 aq[2][4], ak[2][4];
#pragma unroll
        for (int mi = 0; mi < 2; ++mi)
#pragma unroll
            for (int ni = 0; ni < 4; ++ni) { aq[mi][ni] = (f32x4){0.f, 0.f, 0.f, 0.f}; ak[mi][ni] = (f32x4){0.f, 0.f, 0.f, 0.f}; }
        const bf16* Wq = (const bf16*)(ws + WS_WMQ) + h * 16384; const bf16* Wk = (const bf16*)(ws + WS_WMK) + h * 16384;
#pragma unroll
        for (int kk = 0; kk < 4; ++kk) { bf16x8 a[2];
#pragma unroll
            for (int mi = 0; mi < 2; ++mi) a[mi] = *(const LAS bf16x8*)(CA + (32 * wr + 16 * mi + fr) * 136 + 32 * kk + 8 * fq);
#pragma unroll
            for (int ni = 0; ni < 4; ++ni) { const int off = (64 * wcn + 16 * ni + fr) * 128 + 32 * kk + 8 * fq;
                const bf16x8 bq = *(const bf16x8*)(Wq + off), bk = *(const bf16x8*)(Wk + off);
#pragma unroll
                for (int mi = 0; mi < 2; ++mi) { aq[mi][ni] = MFMA16(a[mi], bq, aq[mi][ni]); ak[mi][ni] = MFMA16(a[mi], bk, ak[mi][ni]); } } }
        bf16* QM = (bf16*)(ws + WS_QM); bf16* KM = (bf16*)(ws + WS_KM);
#pragma unroll
        for (int mi = 0; mi < 2; ++mi)
#pragma unroll
            for (int ni = 0; ni < 4; ++ni) { const int col = 64 * wcn + 16 * ni + fr, rowb = 32 * wr + 16 * mi + 4 * fq; float kw[4];
#pragma unroll
                for (int r = 0; r < 4; ++r) { const int row = rowb + r; const size_t o = (size_t)(R0 + row) * 512 + 128 * h + col;
                    QM[o] = f2bf1(aq[mi][ni][r]); const float kv = ak[mi][ni][r] * KSCALE; KM[o] = f2bf1(kv); kw[r] = SAMPLE ? 0.f : kv * wk[row]; }
                if (!SAMPLE) { v2u o2; o2.x = pk2(kw[0], kw[1]); o2.y = pk2(kw[2], kw[3]); *(LAS v2u*)(KT + col * 136 + rowb) = o2; } }
    }
    __syncthreads();
    if (!SAMPLE) {
        f32x4 dc[2][4];
#pragma unroll
        for (int mi = 0; mi < 2; ++mi)
#pragma unroll
            for (int ni = 0; ni < 4; ++ni) dc[mi][ni] = (f32x4){0.f, 0.f, 0.f, 0.f};
#pragma unroll
        for (int kk = 0; kk < 4; ++kk) { bf16x8 a[2], bfr[4];
#pragma unroll
            for (int mi = 0; mi < 2; ++mi) a[mi] = *(const LAS bf16x8*)(VT + (32 * wr + 16 * mi + fr) * 136 + 32 * kk + 8 * fq);
#pragma unroll
            for (int ni = 0; ni < 4; ++ni) bfr[ni] = *(const LAS bf16x8*)(KT + (64 * wcn + 16 * ni + fr) * 136 + 32 * kk + 8 * fq);
#pragma unroll
            for (int mi = 0; mi < 2; ++mi)
#pragma unroll
                for (int ni = 0; ni < 4; ++ni) dc[mi][ni] = MFMA16(a[mi], bfr[ni], dc[mi][ni]); }
        float* DCu = (float*)(ws + WS_DC) + (size_t)u * 16384;
#pragma unroll
        for (int mi = 0; mi < 2; ++mi)
#pragma unroll
            for (int ni = 0; ni < 4; ++ni)
#pragma unroll
                for (int r = 0; r < 4; ++r) DCu[(32 * wr + 16 * mi + 4 * fq + r) * 128 + 64 * wcn + 16 * ni + fr] = dc[mi][ni][r];
        if (tid < 128) { float s = 0.f;
            for (int ss = 0; ss < 128; ss += 2) { const unsigned w = *(const LAS unsigned*)(KT + tid * 136 + ss); s += bflo(w) + bfhi(w); }
            ((float*)(ws + WS_DN))[u * 128 + tid] = s; }
    }
    __syncthreads();
}

__device__ __forceinline__ void attn_core(const LAS bf16* Ks, int ksd, const LAS bf16* VT, int vsd, int p0, int qi, int smin, const bf16x8 (&Qf)[2], float slope, float sink,
                                          const float* g_attn_h, bf16* yrow, bool store, int fr, int fq) {
    float sc[5][8]; float mxv = -INFINITY;
#pragma unroll
    for (int pi = 0; pi < 5; ++pi) { const int pp = p0 + pi; f32x4 s0 = {0.f, 0.f, 0.f, 0.f}, s1 = {0.f, 0.f, 0.f, 0.f};
#pragma unroll
        for (int kk = 0; kk < 2; ++kk) { const bf16x8 a0 = *(const LAS bf16x8*)(Ks + (32 * pp + fr) * ksd + 32 * kk + 8 * fq), a1 = *(const LAS bf16x8*)(Ks + (32 * pp + 16 + fr) * ksd + 32 * kk + 8 * fq);
            s0 = MFMA16(a0, Qf[kk], s0); s1 = MFMA16(a1, Qf[kk], s1); }
#pragma unroll
        for (int r = 0; r < 4; ++r) {
            { const int s = 32 * pp + 4 * fq + r, dist = 128 + qi - s; const bool ok = dist >= 0 && dist < 128 && s >= smin; const float v = ok ? s0[r] * 0.125f - slope * (float)dist : -INFINITY; sc[pi][r] = v; mxv = fmaxf(mxv, v); }
            { const int s = 32 * pp + 16 + 4 * fq + r, dist = 128 + qi - s; const bool ok = dist >= 0 && dist < 128 && s >= smin; const float v = ok ? s1[r] * 0.125f - slope * (float)dist : -INFINITY; sc[pi][4 + r] = v; mxv = fmaxf(mxv, v); }
        } }
    mxv = fmaxf(quad_max(mxv), sink);
    float psum = 0.f; f32x4 o[4];
#pragma unroll
    for (int dt = 0; dt < 4; ++dt) o[dt] = (f32x4){0.f, 0.f, 0.f, 0.f};
#pragma unroll
    for (int pi = 0; pi < 5; ++pi) { const int pp = p0 + pi; float pv[8];
#pragma unroll
        for (int i = 0; i < 8; ++i) { pv[i] = __expf(sc[pi][i] - mxv); psum += pv[i]; }
        const bf16x8 Pf = pack8(pv);
#pragma unroll
        for (int dt = 0; dt < 4; ++dt) { const LAS bf16* vp = VT + (16 * dt + fr) * vsd + 32 * pp + 4 * fq;
            o[dt] = MFMA16(mk8(*(const LAS v2u*)vp, *(const LAS v2u*)(vp + 16)), Pf, o[dt]); } }
    psum = quad_sum(psum);
    const float inv = 1.0f / (psum + __expf(sink - mxv));
    float sum = 0.f;
#pragma unroll
    for (int dt = 0; dt < 4; ++dt) { o[dt] = o[dt] * inv; sum += (o[dt][0] + o[dt][1]) + (o[dt][2] + o[dt][3]); }
    const float mean = quad_sum(sum) * (1.0f / 64.0f); float q = 0.f;
#pragma unroll
    for (int dt = 0; dt < 4; ++dt) { o[dt] = o[dt] - mean; q += (o[dt][0] * o[dt][0] + o[dt][1] * o[dt][1]) + (o[dt][2] * o[dt][2] + o[dt][3] * o[dt][3]); }
    const float rstd = 1.0f / sqrtf(quad_sum(q) * (1.0f / 64.0f) + LN_EPS);
    if (store) {
#pragma unroll
        for (int dt = 0; dt < 4; ++dt) { const int d0 = 16 * dt + 4 * fq; const f32x4 g = *(const f32x4*)(g_attn_h + d0); const f32x4 y = o[dt] * rstd * g;
            v2u w; w.x = pk2(y[0], y[1]); w.y = pk2(y[2], y[3]); *(v2u*)(yrow + d0) = w; }
    }
}
__device__ __forceinline__ void unit_attn_prompt(const Params& p, LAS unsigned char* lds, int tid, int b, int blk, int head) {
    const int lane = tid & 63, wave = __builtin_amdgcn_readfirstlane(tid >> 6), fr = lane & 15, fq = lane >> 4, kvh = head >> 2;
    LAS bf16* Ks = (LAS bf16*)lds; LAS bf16* VT = (LAS bf16*)(lds + 36864);
    const bf16* Z = (const bf16*)(p.ws + WS_Z);
    { const int key = tid >> 1, half = tid & 1, R = row_of(b, 128 * (blk - 1) + key);
#pragma unroll
      for (int i = 0; i < 4; ++i) *(LAS v4u*)(Ks + key * 72 + 32 * half + 8 * i) = *(const v4u*)(Z + (size_t)R * ZW + ZC_K + 64 * kvh + 32 * half + 8 * i); }
    { const int kg = tid >> 3, dg = tid & 7; v4u raw[4];
#pragma unroll
      for (int r = 0; r < 4; ++r) raw[r] = *(const v4u*)(Z + (size_t)row_of(b, 128 * (blk - 1) + 4 * kg + r) * ZW + ZC_V + 64 * kvh + 8 * dg);
      store_vt(VT, 264, 8 * dg, 4 * kg, raw); }
    const int qi = 16 * wave + fr, Rq = b * 4096 + 128 * (blk - 1) + qi;
    bf16x8 Qf[2];
#pragma unroll
    for (int kk = 0; kk < 2; ++kk) Qf[kk] = *(const bf16x8*)(Z + (size_t)Rq * ZW + 64 * head + 32 * kk + 8 * fq);
    __syncthreads();
    attn_core(Ks, 72, VT, 264, wave >> 1, qi, 112 - 128 * (blk - 1), Qf, exp2f(-(float)(head + 1)), p.in[I_SINK][head], p.in[I_GATT] + 64 * head,
              (bf16*)(p.ws + WS_Y) + (size_t)Rq * 1024 + 64 * head, true, fr, fq);
    __syncthreads();
}
__device__ __forceinline__ void unit_attn_sample(const Params& p, LAS unsigned char* lds, int tid, int n) {
    const int lane = tid & 63, wave = __builtin_amdgcn_readfirstlane(tid >> 6), fr = lane & 15, fq = lane >> 4, head = wave, kvh = head >> 2;
    LAS bf16* Ks = (LAS bf16*)lds; LAS bf16* VT = (LAS bf16*)(lds + 46080);
    const bf16* Z = (const bf16*)(p.ws + WS_Z);
    for (int t = tid; t < 2560; t += NTHR) { const int c = t & 7, key = (t >> 3) % 160, kv = t / 1280; v4u o = {0u, 0u, 0u, 0u};
        if (key < 128) { const float* s = p.in[I_CK] + ((size_t)(n * 128 + key) * 2 + kv) * 64 + 8 * c; const f32x4 a = *(const f32x4*)s, bq = *(const f32x4*)(s + 4);
            o.x = pk2(a[0], a[1]); o.y = pk2(a[2], a[3]); o.z = pk2(bq[0], bq[1]); o.w = pk2(bq[2], bq[3]); }
        else if (key < 136) o = *(const v4u*)(Z + (size_t)(R_SAMPLE + 8 * n + key - 128) * ZW + ZC_K + 64 * kv + 8 * c);
        *(LAS v4u*)(Ks + (kv * 160 + key) * 72 + 8 * c) = o; }
    for (int t = tid; t < 640; t += NTHR) { const int dg = t & 7, kg = (t >> 3) % 40, kv = t / 320; v4u raw[4];
#pragma unroll
        for (int r = 0; r < 4; ++r) { const int key = 4 * kg + r; v4u o = {0u, 0u, 0u, 0u};
            if (key < 128) { const float* s = p.in[I_CV] + ((size_t)(n * 128 + key) * 2 + kv) * 64 + 8 * dg; const f32x4 a = *(const f32x4*)s, bq = *(const f32x4*)(s + 4);
                o.x = pk2(a[0], a[1]); o.y = pk2(a[2], a[3]); o.z = pk2(bq[0], bq[1]); o.w = pk2(bq[2], bq[3]); }
            else if (key < 136) o = *(const v4u*)(Z + (size_t)(R_SAMPLE + 8 * n + key - 128) * ZW + ZC_V + 64 * kv + 8 * dg);
            raw[r] = o; }
        store_vt(VT + kv * 64 * 168, 168, 8 * dg, 4 * kg, raw); }
    __syncthreads();
    const int qi = fr, Rq = R_SAMPLE + 8 * n + (fr & 7);
    bf16x8 Qf[2];
#pragma unroll
    for (int kk = 0; kk < 2; ++kk) { v4u q = *(const v4u*)(Z + (size_t)Rq * ZW + 64 * head + 32 * kk + 8 * fq); if (fr >= 8) q = (v4u){0u, 0u, 0u, 0u}; Qf[kk] = __builtin_bit_cast(bf16x8, q); }
    attn_core(Ks + kvh * 160 * 72, 72, VT + kvh * 64 * 168, 168, 0, qi, 0, Qf, exp2f(-(float)(head + 1)), p.in[I_SINK][head], p.in[I_GATT] + 64 * head,
              (bf16*)(p.ws + WS_Y) + (size_t)Rq * 1024 + 64 * head, fr < 8, fr, fq);
    __syncthreads();
}

__device__ __forceinline__ void unit_mlstm_sample(const Params& p, LAS unsigned char* lds, int tid, int n, int h) {
    const int lane = tid & 63, wave = __builtin_amdgcn_readfirstlane(tid >> 6);
    LAS float* ca = (LAS float*)lds; LAS float* qs = ca + 1024; LAS float* ks = qs + 1024; LAS float* vs = ks + 1024; LAS float* hs = vs + 1024;
    LAS float* sm = hs + 1024;
    LAS float* s_li = sm, *s_lf = sm + 8, *s_ga = sm + 16, *s_mu = sm + 24, *s_wi = sm + 32, *s_mt = sm + 40, *s_wk = sm + 48, *s_nq = sm + 56, *s_Sd = sm + 64, *s_sc = sm + 128, *s_raw = sm + 136;
    const bf16* Z = (const bf16*)(p.ws + WS_Z); const float* gates = (const float*)(p.ws + WS_GATES);
    const int R0 = R_SAMPLE + 8 * n, nh = n * 4 + h;
    const int vv = tid >> 2, part = tid & 3;
    float C[32];
    {   const float* cp = p.in[I_SC] + ((size_t)nh * 128 + vv) * 128 + 32 * part;
#pragma unroll
        for (int i = 0; i < 8; ++i) { const f32x4 c4 = *(const f32x4*)(cp + 4 * i); C[4 * i] = c4[0]; C[4 * i + 1] = c4[1]; C[4 * i + 2] = c4[2]; C[4 * i + 3] = c4[3]; } }
    const float og0 = bf2f(Z[(size_t)(R0 + 2 * part) * ZW + ZC_O + 128 * h + vv]), og1 = bf2f(Z[(size_t)(R0 + 2 * part + 1) * ZW + ZC_O + 128 * h + vv]);
    {
        const int l = tid >> 6, cc = tid & 63; const size_t o = (size_t)(R0 + l) * 512 + 128 * h + 2 * cc;
        const unsigned qw = *(const unsigned*)((const bf16*)(p.ws + WS_QM) + o), kw = *(const unsigned*)((const bf16*)(p.ws + WS_KM) + o);
        const unsigned vw = *(const unsigned*)(Z + (size_t)(R0 + l) * ZW + ZC_VM + 128 * h + 2 * cc);
        qs[l * 128 + 2 * cc] = bflo(qw); qs[l * 128 + 2 * cc + 1] = bfhi(qw); ks[l * 128 + 2 * cc] = bflo(kw); ks[l * 128 + 2 * cc + 1] = bfhi(kw);
        vs[l * 128 + 2 * cc] = bflo(vw); vs[l * 128 + 2 * cc + 1] = bfhi(vw);
        if (tid < 128) ca[tid] = p.in[I_SN][(size_t)nh * 128 + tid];
        if (tid < 8) { const float* g = gates + (size_t)(R0 + tid) * 8; s_li[tid] = g[h] + p.in[I_BI][h]; s_lf[tid] = logsig_f(g[4 + h] + p.in[I_BF][h]); }
    }
    __syncthreads();
    if (tid < 8) {
        const float m_s = p.in[I_SM][nh]; float bsum = 0.f, mxr = -INFINITY, a = 0.f;
        for (int l = 0; l <= tid; ++l) { bsum += s_lf[l]; a = s_li[l] - bsum; mxr = fmaxf(mxr, a); }
        const float mu = fmaxf(m_s, mxr), mu_last = __shfl(mu, 7), mt = bsum + mu;
        s_ga[tid] = a; s_mu[tid] = mu; s_wi[tid] = __expf(m_s - mu); s_mt[tid] = mt; s_wk[tid] = __expf(a - mu_last);
        if (tid == 7) { s_sc[0] = __expf(m_s - mu_last); p.out[O_SM + nh] = mt; }
    }
    if (tid >= 64 && tid < 64 + 288) {
        const int id = (tid - 64) >> 2, pq = tid & 3; const LAS float* ap = qs + (id < 64 ? (id >> 3) : (id - 64)) * 128 + 32 * pq; const LAS float* bp = (id < 64 ? ks + (id & 7) * 128 : ca) + 32 * pq;
        float dot = 0.f;
#pragma unroll
        for (int k = 0; k < 32; ++k) dot += ap[k] * bp[k];
        dot += __shfl_xor(dot, 1); dot += __shfl_xor(dot, 2);
        if (pq == 0) s_raw[id] = dot; }
    __syncthreads();
    if (tid < 64) { const int t = tid >> 3, s2 = tid & 7; s_Sd[tid] = (s2 <= t) ? s_raw[tid] * __expf(s_ga[s2] - s_mu[t]) : 0.f; }
    else if (tid < 72) s_nq[tid - 64] = s_raw[tid];
    __syncthreads();
    {   const float decay = s_sc[0];
#pragma unroll
        for (int t = 0; t < 8; ++t) { float s = 0.f;
#pragma unroll
            for (int k = 0; k < 32; ++k) s += C[k] * qs[t * 128 + 32 * part + k];
            s += __shfl_xor(s, 1); s += __shfl_xor(s, 2);
            if ((t >> 1) == part) { float num = s_wi[t] * s, den = s_wi[t] * s_nq[t];
#pragma unroll
                for (int s2 = 0; s2 < 8; ++s2) { const float w = s_Sd[t * 8 + s2]; num += w * vs[s2 * 128 + vv]; den += w; }
                const float hval = num / fmaxf(fabsf(den), __expf(-s_mt[t]));
                hs[t * 128 + vv] = sigmoid_f((t & 1) ? og1 : og0) * hval; } }
        float wv[8];
#pragma unroll
        for (int s2 = 0; s2 < 8; ++s2) wv[s2] = s_wk[s2] * vs[s2 * 128 + vv];
        float* op = p.out + O_SC + ((size_t)nh * 128 + vv) * 128 + 32 * part;
#pragma unroll
        for (int i = 0; i < 8; ++i) { f32x4 o4;
#pragma unroll
            for (int e = 0; e < 4; ++e) { float acc = decay * C[4 * i + e];
#pragma unroll
                for (int s2 = 0; s2 < 8; ++s2) acc += wv[s2] * ks[s2 * 128 + 32 * part + 4 * i + e];
                o4[e] = acc; }
            *(f32x4*)(op + 4 * i) = o4; }
        if (tid < 128) { float acc = decay * ca[tid];
#pragma unroll
            for (int s2 = 0; s2 < 8; ++s2) acc += s_wk[s2] * ks[s2 * 128 + tid];
            p.out[O_SN + (size_t)nh * 128 + tid] = acc; }
    }
    __syncthreads();
    {
        const int t = wave; const float v0 = hs[t * 128 + 2 * lane], v1 = hs[t * 128 + 2 * lane + 1];
        const float mean = wave_sum(v0 + v1) * (1.0f / 128.0f); const float d0 = v0 - mean, d1 = v1 - mean;
        const float rstd = 1.0f / sqrtf(wave_sum(d0 * d0 + d1 * d1) * (1.0f / 128.0f) + LN_EPS);
        const float* g = p.in[I_GML] + 128 * h + 2 * lane;
        *(unsigned*)((bf16*)(p.ws + WS_Y) + (size_t)(R0 + t) * 1024 + 512 + 128 * h + 2 * lane) = pk2(d0 * rstd * g[0], d1 * rstd * g[1]);
    }
    __syncthreads();
}

__device__ __forceinline__ void p2_copies(const Params& p, int tid) {
    const bf16* Z = (const bf16*)(p.ws + WS_Z); float* out = p.out;
    const int gt = blockIdx.x * NTHR + tid, GS = gridDim.x * NTHR;
    constexpr int NA = 2 * 128 * 3840;
#pragma unroll 4
    for (int i = gt; i < NA; i += GS) { const int which = i >= NA / 2, r = i - which * (NA / 2), n = r / 3840, o4 = r - n * 3840;
        const f32x4 v = *(const f32x4*)(p.in[which ? I_CV : I_CK] + (size_t)n * 16384 + 1024 + 4 * o4);
        *(f32x4*)(out + (which ? O_SV : O_SK) + (size_t)n * 16384 + 4 * o4) = v; }
    constexpr int B0 = 2 * 16384, B1 = B0 + 1536, B2 = B1 + 2 * 32768, NBq = B2 + 49152;
#pragma unroll 4
    for (int i = gt; i < NBq; i += GS) {
        int row, col; size_t dst;
        if (i < B0) { const int which = i >= 16384, r = i & 16383, b = r >> 12, w = (r >> 5) & 127, c4 = r & 31; row = b * 4096 + 3968 + w; col = (which ? ZC_V : ZC_K) + 4 * c4; dst = (which ? O_PV : O_PK) + (size_t)r * 4; }
        else if (i < B1) { const int r = i - B0, b = r / 384, rr = (r / 128) % 3, c4 = r & 127; row = b * 4096 + 4093 + rr; col = ZC_C + 4 * c4; dst = O_PCONV + (size_t)r * 4; }
        else if (i < B2) { const int r0 = i - B1, which = r0 >= 32768, r = r0 & 32767, n = r >> 8, w = (r >> 5) & 7, c4 = r & 31; row = R_SAMPLE + 8 * n + w; col = (which ? ZC_V : ZC_K) + 4 * c4;
            dst = (which ? O_SV : O_SK) + (size_t)n * 16384 + (size_t)(120 + w) * 128 + 4 * c4; }
        else { const int r = i - B2, n = r / 384, rr = (r / 128) % 3, c4 = r & 127; row = R_SAMPLE + 8 * n + 5 + rr; col = ZC_C + 4 * c4; dst = O_SCONV + (size_t)r * 4; }
        const v2u raw = *(const v2u*)(Z + (size_t)row * ZW + col);
        *(f32x4*)(out + dst) = (f32x4){bflo(raw.x), bfhi(raw.x), bflo(raw.y), bfhi(raw.y)};
    }
}

__device__ __forceinline__ void p3_scan(const Params& p, int tid) {
    unsigned char* ws = p.ws; const float* DC = (const float*)(ws + WS_DC); const float* DN = (const float*)(ws + WS_DN); const float* CSUM = (const float*)(ws + WS_CSUM);
    float* SCAL = (float*)(ws + WS_SCAL); bf16* CS = (bf16*)(ws + WS_CS); float* NS = (float*)(ws + WS_NS);
    for (int g = blockIdx.x * NTHR + tid; g < 131072; g += gridDim.x * NTHR) {
        const int bh = g >> 13, b = bh >> 2, h = bh & 3, e2 = g & 8191;
        float c0 = 0.f, c1 = 0.f, m = 0.f;
        for (int jb = 0; jb < 33; jb += 11) { f32x2 d[11], cs[11];
#pragma unroll
            for (int i = 0; i < 11; ++i) { const int u = (b * 33 + jb + i) * 4 + h; d[i] = *(const f32x2*)(DC + (size_t)u * 16384 + 2 * e2); cs[i] = *(const f32x2*)(CSUM + 2 * u); }
#pragma unroll
            for (int i = 0; i < 11; ++i) { const int u = (b * 33 + jb + i) * 4 + h; *(unsigned*)(CS + (size_t)u * 16384 + 2 * e2) = pk2(c0, c1);
                const float Ml = cs[i][1], mu = fmaxf(m, Ml), dec = __expf(m - mu), scl = __expf(Ml - mu);
                if (e2 == 0) *(f32x4*)(SCAL + u * 4) = (f32x4){m, dec, cs[i][0] + mu, 0.f};
                c0 = dec * c0 + scl * d[i][0]; c1 = dec * c1 + scl * d[i][1]; m = cs[i][0] + mu; } }
        *(f32x2*)(p.out + O_PC + (size_t)bh * 16384 + 2 * e2) = (f32x2){c0, c1};
        if (e2 == 0) p.out[O_PM + bh] = m;
        if (e2 < 64) { float n0 = 0.f, n1 = 0.f; m = 0.f;
            for (int jb = 0; jb < 33; jb += 11) { f32x2 d[11], cs[11];
#pragma unroll
                for (int i = 0; i < 11; ++i) { const int u = (b * 33 + jb + i) * 4 + h; d[i] = *(const f32x2*)(DN + u * 128 + 2 * e2); cs[i] = *(const f32x2*)(CSUM + 2 * u); }
#pragma unroll
                for (int i = 0; i < 11; ++i) { const int u = (b * 33 + jb + i) * 4 + h; *(f32x2*)(NS + u * 128 + 2 * e2) = (f32x2){n0, n1};
                    const float Ml = cs[i][1], mu = fmaxf(m, Ml), dec = __expf(m - mu), scl = __expf(Ml - mu);
                    n0 = dec * n0 + scl * d[i][0]; n1 = dec * n1 + scl * d[i][1]; m = cs[i][0] + mu; } }
            *(f32x2*)(p.out + O_PN + bh * 128 + 2 * e2) = (f32x2){n0, n1}; }
    }
}

__device__ __forceinline__ void unit_mlstm_b(const Params& p, LAS unsigned char* lds, int tid, int b, int j, int h) {
    const int lane = tid & 63, wave = __builtin_amdgcn_readfirstlane(tid >> 6), fr = lane & 15, fq = lane >> 4;
    LAS bf16* KMs = (LAS bf16*)lds; LAS bf16* VT = (LAS bf16*)(lds + 34816); LAS bf16* CSs = (LAS bf16*)(lds + 69632);
    LAS float* aA = (LAS float*)(lds + 104448); LAS float* bA = aA + 128; LAS float* mxA = bA + 128; LAS float* nsA = mxA + 128;
    unsigned char* ws = p.ws;
    const bf16* Z = (const bf16*)(ws + WS_Z); const bf16* QM = (const bf16*)(ws + WS_QM); const bf16* KM = (const bf16*)(ws + WS_KM); const bf16* CS = (const bf16*)(ws + WS_CS);
    const int u = (b * 33 + j) * 4 + h, R0 = b * 4096 + 128 * (j - 1);
    { const int row = tid >> 2, part = tid & 3;
#pragma unroll
      for (int i = 0; i < 4; ++i) { *(LAS v4u*)(KMs + row * 136 + 32 * part + 8 * i) = *(const v4u*)(KM + (size_t)(R0 + row) * 512 + 128 * h + 32 * part + 8 * i);
          *(LAS v4u*)(CSs + row * 136 + 32 * part + 8 * i) = *(const v4u*)(CS + (size_t)u * 16384 + row * 128 + 32 * part + 8 * i); } }
    { const int rg = tid >> 4, c8 = tid & 15; v4u raw[4];
#pragma unroll
      for (int r = 0; r < 4; ++r) raw[r] = *(const v4u*)(Z + (size_t)(R0 + 4 * rg + r) * ZW + ZC_VM + 128 * h + 8 * c8);
      store_vt(VT, 136, 8 * c8, 4 * rg, raw); }
    if (tid < 128) { const f32x4 tg = *(const f32x4*)((const float*)(ws + WS_TOKG) + ((size_t)(R0 + tid) * 4 + h) * 4); aA[tid] = tg[0]; bA[tid] = tg[1]; mxA[tid] = tg[2]; }
    else if (tid < 256) nsA[tid - 128] = ((const float*)(ws + WS_NS))[u * 128 + tid - 128];
    const float m_s = ((const float*)(ws + WS_SCAL))[u * 4];
    const int t = 16 * wave + fr, Rt = R0 + t;
    bf16x8 Qf[4]; v2u og[8];
#pragma unroll
    for (int kk = 0; kk < 4; ++kk) Qf[kk] = *(const bf16x8*)(QM + (size_t)Rt * 512 + 128 * h + 32 * kk + 8 * fq);
#pragma unroll
    for (int vt = 0; vt < 8; ++vt) og[vt] = *(const v2u*)(Z + (size_t)Rt * ZW + ZC_O + 128 * h + 16 * vt + 4 * fq);
    __syncthreads();
    const float mu_t = fmaxf(m_s, mxA[t]), w_int = __expf(m_s - mu_t), m_t = bA[t] + mu_t;
    f32x4 oi[8], oe[8];
#pragma unroll
    for (int vt = 0; vt < 8; ++vt) { oi[vt] = (f32x4){0.f, 0.f, 0.f, 0.f}; oe[vt] = (f32x4){0.f, 0.f, 0.f, 0.f}; }
    float dsum = 0.f;
    const int npair = (wave >> 1) + 1;
    for (int pp = 0; pp < npair; ++pp) {
        f32x4 s0 = {0.f, 0.f, 0.f, 0.f}, s1 = {0.f, 0.f, 0.f, 0.f};
#pragma unroll
        for (int kk = 0; kk < 4; ++kk) { const bf16x8 a0 = *(const LAS bf16x8*)(KMs + (32 * pp + fr) * 136 + 32 * kk + 8 * fq), a1 = *(const LAS bf16x8*)(KMs + (32 * pp + 16 + fr) * 136 + 32 * kk + 8 * fq);
            s0 = MFMA16(a0, Qf[kk], s0); s1 = MFMA16(a1, Qf[kk], s1); }
        float pv[8];
#pragma unroll
        for (int r = 0; r < 4; ++r) { const int sa = 32 * pp + 4 * fq + r, sb = sa + 16;
            pv[r] = (sa <= t) ? s0[r] * __expf(aA[sa] - mu_t) : 0.f; pv[4 + r] = (sb <= t) ? s1[r] * __expf(aA[sb] - mu_t) : 0.f; dsum += pv[r] + pv[4 + r]; }
        const bf16x8 Pf = pack8(pv);
#pragma unroll
        for (int vt = 0; vt < 8; ++vt) { const LAS bf16* vp = VT + (16 * vt + fr) * 136 + 32 * pp + 4 * fq;
            oi[vt] = MFMA16(mk8(*(const LAS v2u*)vp, *(const LAS v2u*)(vp + 16)), Pf, oi[vt]); }
    }
#pragma unroll
    for (int kk = 0; kk < 4; ++kk)
#pragma unroll
        for (int vt = 0; vt < 8; ++vt) oe[vt] = MFMA16(*(const LAS bf16x8*)(CSs + (16 * vt + fr) * 136 + 32 * kk + 8 * fq), Qf[kk], oe[vt]);
    float nq = 0.f;
#pragma unroll
    for (int kk = 0; kk < 4; ++kk)
#pragma unroll
        for (int jx = 0; jx < 8; ++jx) nq += nsA[32 * kk + 8 * fq + jx] * bf2f((unsigned short)Qf[kk][jx]);
    nq = quad_sum(nq); dsum = quad_sum(dsum);
    const float den = dsum + w_int * nq, inv = 1.0f / fmaxf(fabsf(den), __expf(-m_t));
    float sum = 0.f;
#pragma unroll
    for (int vt = 0; vt < 8; ++vt) { const v2u raw = og[vt];
        const float op[4] = {bflo(raw.x), bfhi(raw.x), bflo(raw.y), bfhi(raw.y)};
#pragma unroll
        for (int r = 0; r < 4; ++r) { const float hv = (oi[vt][r] + w_int * oe[vt][r]) * inv * sigmoid_f(op[r]); oi[vt][r] = hv; sum += hv; } }
    const float mean = quad_sum(sum) * (1.0f / 128.0f); float q = 0.f;
#pragma unroll
    for (int vt = 0; vt < 8; ++vt) { oi[vt] = oi[vt] - mean; q += (oi[vt][0] * oi[vt][0] + oi[vt][1] * oi[vt][1]) + (oi[vt][2] * oi[vt][2] + oi[vt][3] * oi[vt][3]); }
    const float rstd = 1.0f / sqrtf(quad_sum(q) * (1.0f / 128.0f) + LN_EPS);
    bf16* yrow = (bf16*)(ws + WS_Y) + (size_t)Rt * 1024 + 512 + 128 * h;
#pragma unroll
    for (int vt = 0; vt < 8; ++vt) { const int v0 = 16 * vt + 4 * fq; const f32x4 g = *(const f32x4*)(p.in[I_GML] + 128 * h + v0); const f32x4 y = oi[vt] * rstd * g;
        v2u w; w.x = pk2(y[0], y[1]); w.y = pk2(y[2], y[3]); *(v2u*)(yrow + v0) = w; }
    __syncthreads();
}

__device__ __forceinline__ void ln_load_bf16(const bf16* xrow, int lane, f32x4 (&v)[4]) {
#pragma unroll
    for (int jx = 0; jx < 4; ++jx) { const v2u w = ((const v2u*)xrow)[lane + 64 * jx]; v[jx] = (f32x4){bflo(w.x), bfhi(w.x), bflo(w.y), bfhi(w.y)}; }
}
__device__ __forceinline__ void ln_rows(const bf16* x, float* of, bf16* ob, const float* g, const float* bta, const float* res, float* ofS, const float* sl0, int n0, const float* sl1, int n1, int tid) {
    const int lane = tid & 63, wave = __builtin_amdgcn_readfirstlane(tid >> 6);
    const int RS = gridDim.x * 8;
    f32x4 vn[4];
    { const int R = blockIdx.x * 8 + wave; if (R < R_SAMPLE) ln_load_bf16(x + (size_t)R * 1024, lane, vn); }
    for (int R = blockIdx.x * 8 + wave; R < MMAIN; R += RS) {
        f32x4 v[4]; float s = 0.f; f32x4* orow = nullptr;
        if (R < R_SAMPLE) { if (of) orow = (f32x4*)(of + (size_t)R * 1024) + lane;
#pragma unroll
            for (int jx = 0; jx < 4; ++jx) v[jx] = vn[jx];
            if (R + RS < R_SAMPLE) ln_load_bf16(x + (size_t)(R + RS) * 1024, lane, vn);
        } else { const size_t ro = (size_t)(R - R_SAMPLE) * 1024; const f32x4* xr = (const f32x4*)(res + ro) + lane; orow = (f32x4*)(ofS + ro) + lane;
#pragma unroll
            for (int jx = 0; jx < 4; ++jx) v[jx] = xr[64 * jx] * ALPHA;
            for (int sidx = 0; sidx < n0; ++sidx) { const f32x4* sr = (const f32x4*)(sl0 + (size_t)sidx * 1048576 + ro) + lane;
#pragma unroll
                for (int jx = 0; jx < 4; ++jx) v[jx] += sr[64 * jx]; }
            for (int sidx = 0; sidx < n1; ++sidx) { const f32x4* sr = (const f32x4*)(sl1 + (size_t)sidx * 1048576 + ro) + lane;
#pragma unroll
                for (int jx = 0; jx < 4; ++jx) v[jx] += sr[64 * jx]; }
        }
#pragma unroll
        for (int jx = 0; jx < 4; ++jx) s += (v[jx][0] + v[jx][1]) + (v[jx][2] + v[jx][3]);
        const float mean = wave_sum(s) * (1.0f / 1024.0f); float s2 = 0.f;
#pragma unroll
        for (int jx = 0; jx < 4; ++jx) { v[jx] = v[jx] - mean; s2 += (v[jx][0] * v[jx][0] + v[jx][1] * v[jx][1]) + (v[jx][2] * v[jx][2] + v[jx][3] * v[jx][3]); }
        const float rstd = 1.0f / sqrtf(wave_sum(s2) * (1.0f / 1024.0f) + LN_EPS);
#pragma unroll
        for (int jx = 0; jx < 4; ++jx) { const f32x4 y = v[jx] * rstd * ((const f32x4*)g)[lane + 64 * jx] + ((const f32x4*)bta)[lane + 64 * jx];
            if (orow) orow[64 * jx] = y;
            if (ob) ((unsigned long long*)(ob + (size_t)R * 1024))[lane + 64 * jx] = (unsigned long long)pk2(y[0], y[1]) | ((unsigned long long)pk2(y[2], y[3]) << 32); }
    }
}

#define XB_TMO      128
#define XB_XCNT(j)  (256  + 64 * (j))
#define XB_XSUB(j)  (1280 + 64 * (j))
#define XB_XGEN(j)  (2304 + 64 * (j))
#define XB_TOP      3328
#define XB_TOPGEN   3392
#define XCD_BAR_WORDS 3456
#define XB_SPIN_CAP (1u << 18)

__device__ __forceinline__ unsigned xb_ld(unsigned* p)              { return __hip_atomic_load(p, __ATOMIC_RELAXED, __HIP_MEMORY_SCOPE_AGENT); }
__device__ __forceinline__ unsigned xb_add(unsigned* p, unsigned v) { return __hip_atomic_fetch_add(p, v, __ATOMIC_RELAXED, __HIP_MEMORY_SCOPE_AGENT); }
__device__ __forceinline__ unsigned xb_xcc_id() { return (unsigned)__builtin_amdgcn_s_getreg((3 << 11) | 20) & 0xFu; }
#define XB_SPIN(cond, bar) do { unsigned _sp = 0; while (cond) { __builtin_amdgcn_s_sleep(1); \
    if ((++_sp & 255u) == 0u) { if (xb_ld(&(bar)[XB_TMO])) break; if (_sp > XB_SPIN_CAP) { atomicAdd(&(bar)[XB_TMO], 1u); break; } } } } while (0)

struct XcdBarrier {
    unsigned* bar; unsigned x;
    volatile LAS unsigned* st;
};

__device__ __forceinline__ XcdBarrier xcd_barrier_post(unsigned* bar, volatile LAS unsigned* st) {
    XcdBarrier b; b.bar = bar; b.x = xb_xcc_id(); b.st = st;
    if (threadIdx.x == 0) (void)xb_add(&bar[XB_XCNT(b.x)], 1u);
    return b;
}
__device__ __forceinline__ void xcd_barrier_complete(unsigned* bar, unsigned x, unsigned& nloc, unsigned& nx) {
    const unsigned G = gridDim.x * gridDim.y * gridDim.z;
    unsigned sum, cnt, mine, sp = 0u;
    for (;;) {
        sum = 0u; cnt = 0u; mine = 0u;
#pragma unroll
        for (unsigned j = 0; j < 16; ++j) { const unsigned c = xb_ld(&bar[XB_XCNT(j)]); sum += c; cnt += (c > 0u) ? 1u : 0u; mine = (j == x) ? c : mine; }
        if (sum == G) break;
        __builtin_amdgcn_s_sleep(1);
        if ((++sp & 255u) == 0u) { if (xb_ld(&bar[XB_TMO])) break; if (sp > XB_SPIN_CAP) { atomicAdd(&bar[XB_TMO], 1u); break; } }
    }
    nloc = mine > 0u ? mine : 1u; nx = cnt > 0u ? cnt : 1u;
}

__device__ __forceinline__ void xcd_barrier(const XcdBarrier& b) {
    asm volatile("s_waitcnt vmcnt(0)" ::: "memory");
    __syncthreads();
    if (threadIdx.x == 0) {
        unsigned* bar = b.bar;
        __builtin_amdgcn_s_waitcnt(0);
        unsigned nloc = b.st[0], nx = b.st[1];
        if (nloc == 0u) { xcd_barrier_complete(bar, b.x, nloc, nx); b.st[0] = nloc; b.st[1] = nx; }
        const unsigned old = xb_add(&bar[XB_XSUB(b.x)], 1u);
        const unsigned gen = old / nloc;
        if (old + 1u == (gen + 1u) * nloc) {
            __builtin_amdgcn_fence(__ATOMIC_RELEASE, "agent");
            asm volatile("s_waitcnt vmcnt(0)" ::: "memory");
            const unsigned og = xb_add(&bar[XB_TOP], 1u);
            const unsigned tg = og / nx;
            if (og + 1u == (tg + 1u) * nx) xb_add(&bar[XB_TOPGEN], 1u);
            else XB_SPIN(xb_ld(&bar[XB_TOPGEN]) == tg, bar);
            __builtin_amdgcn_fence(__ATOMIC_ACQUIRE, "agent");
            xb_add(&bar[XB_XGEN(b.x)], 1u);
            asm volatile("s_waitcnt vmcnt(0)" ::: "memory");
        } else {
            XB_SPIN(xb_ld(&bar[XB_XGEN(b.x)]) == gen, bar);
            __builtin_amdgcn_fence(__ATOMIC_ACQUIRE, "agent");
            asm volatile("s_waitcnt vmcnt(0)" ::: "memory");
        }
    }
    __syncthreads();
}

constexpr int NU_MA = 528, NU_AP = 1024, NU_MS = 32, NU_AS = 128;
constexpr int NU_P2 = NU_MA + NU_AP + NU_MS + NU_AS;
constexpr int PROBE_SYNCS = 0; constexpr unsigned PROBE_REP = 0u;
__global__ void __launch_bounds__(NTHR, 2) hymba_fwd(Params p) {
    extern __shared__ __attribute__((aligned(16))) unsigned char lds_raw[];
    LAS unsigned char* lds = (LAS unsigned char*)lds_raw;
    cg::grid_group grid = cg::this_grid();
    const int tid = threadIdx.x;
    unsigned char* ws = p.ws;
    const int lo = p.ph_lo, hi = p.ph_hi;
    volatile LAS unsigned* MISC = (volatile LAS unsigned*)(lds + 131072);
    if (tid < 32) MISC[tid] = 0u;
    __syncthreads();
    XcdBarrier bar = xcd_barrier_post((unsigned*)ws, MISC + 8);
    if (lo < 0) grid.sync();
#define IN(k) (lo <= (k) && (k) < hi)
#define REP(k) for (int rep_ = 0; rep_ < (((PROBE_REP >> (k)) & 1u) ? 2 : 1); ++rep_, (((PROBE_REP >> (k)) & 1u) && rep_ < 2 ? xcd_barrier(bar) : (void)0))
#define SEAM(k) do { if (IN(k) && IN((k) + 1)) xcd_barrier(bar); } while (0)
    REP(0) if (IN(0)) p0_prologue(p, lds, tid);
    SEAM(0);
    REP(1) if (IN(1)) {
        pg8::Gemm g{(const pg8::bf16_t*)(ws + WS_XB), (const pg8::bf16_t*)(ws + WS_WIN), MROWS, ZW, 1024}; pg8::StaticOrder S; S.init(MROWS, ZW, (int)gridDim.x, (int)blockIdx.x, 1024);
        pg8::EpiStoreBf16 E{(pg8::bf16_t*)(ws + WS_Z), ZW};
        pg8::gemm_phase<pg8::EpiStoreBf16, pg8::StaticOrder, true, true>(lds, g, S, E);
        {
            const int G = (int)gridDim.x, c = (int)blockIdx.x, nwg = (MROWS / 256) * (ZW / 256), nmax = (nwg + G - 1) / G, mine = nwg > c ? (nwg - c + G - 1) / G : 0;
            const int first = nwg - (nmax - 1) * G;
            const int nidle = (first >= G || first < 0) ? G : G - first, rank = (first >= G || first < 0) ? c : c - first;
            if (mine < nmax || nidle == G) { int tid3 = threadIdx.x; asm volatile("" : "+v"(tid3)); p0_items(p, lds, tid3, P0_I_IN, P0_NIT, rank * 8 + (tid3 >> 6), nidle * 8); }
        }
    }
    SEAM(1);
    REP(2) if (IN(2)) {
        for (int u = blockIdx.x; u < NU_P2; u += gridDim.x) {
            int r = u; int tid = threadIdx.x; asm volatile("" : "+v"(tid));
            if (r < NU_MA) { unit_mlstm_a<false>(p, lds, tid, r / 132, (r / 4) % 33, r & 3); continue; } r -= NU_MA;
            if (r < NU_AP) { unit_attn_prompt(p, lds, tid, r >> 8, 1 + ((r >> 3) & 31), r & 7); continue; } r -= NU_AP;
            if (r < NU_MS) { unit_mlstm_a<true>(p, lds, tid, r >> 2, 0, r & 3); continue; } r -= NU_MS;
            unit_attn_sample(p, lds, tid, r);
        }
        p2_copies(p, tid);
    }
    SEAM(2);
    REP(3) if (IN(3)) p3_scan(p, tid);
    SEAM(3);
    REP(4) if (IN(4)) { for (int u = blockIdx.x; u < 1024; u += gridDim.x) { int tid2 = threadIdx.x; asm volatile("" : "+v"(tid2));
            if (u < 512) unit_mlstm_b(p, lds, tid2, u >> 7, 1 + ((u >> 2) & 31), u & 3); else unit_mlstm_sample(p, lds, tid2, (u - 512) >> 2, u & 3); } }
    SEAM(4);
    REP(5) if (IN(5)) {
        pg8::Gemm g{(const pg8::bf16_t*)(ws + WS_Y), (const pg8::bf16_t*)(ws + WS_WOUT), MMAIN, 1024, 1024}; pg8::TailOrder<4> S; S.init(1024, (int)gridDim.x, (int)blockIdx.x, 1024);
        typedef pg8::EpiResSlab<false, 4, 256, (long)(WS_SLABB / 4), (long)(WS_SLABB / 4)> Epi5; Epi5 E{(const void*)p.in[I_XP], (pg8::bf16_t*)(ws + WS_T1), (float*)ws};
        pg8::gemm_phase<Epi5, pg8::TailOrder<4>, true, true, true>(lds, g, S, E);
    }
    SEAM(5);
    if (IN(6)) ln_rows((const bf16*)(ws + WS_T1), nullptr, (bf16*)(ws + WS_X1B), p.in[I_LN1G], p.in[I_LN1B], p.in[I_XS], (float*)(ws + WS_X1S), (const float*)(ws + WS_SLABB), 4, nullptr, 0, tid);
    SEAM(6);
    REP(7) if (IN(7)) {
        pg8::Gemm g{(const pg8::bf16_t*)(ws + WS_X1B), (const pg8::bf16_t*)(ws + WS_WGU), MMAIN, 2 * DFF, 1024}; pg8::StaticOrder S; S.init(MMAIN, 2 * DFF, (int)gridDim.x, (int)blockIdx.x, 1024);
        pg8::EpiSwiGLU E{(pg8::bf16_t*)(ws + WS_H), DFF};
        pg8::gemm_phase<pg8::EpiSwiGLU, pg8::StaticOrder, true, true>(lds, g, S, E);
    }
    SEAM(7);
    REP(8) if (IN(8)) {
        pg8::Gemm g{(const pg8::bf16_t*)(ws + WS_H), (const pg8::bf16_t*)(ws + WS_WDN), MMAIN, 1024, DFF}; pg8::TailOrder<11> S; S.init(1024, (int)gridDim.x, (int)blockIdx.x, DFF);
        typedef pg8::EpiResSlab<true, 8, 256, (long)(WS_SLABA / 4), (long)(WS_SLABB / 4)> Epi8; Epi8 E{(const void*)(ws + WS_X1B), (pg8::bf16_t*)(ws + WS_T2B), (float*)ws};
        pg8::gemm_phase<Epi8, pg8::TailOrder<11>, true, true, true>(lds, g, S, E);
    }
    SEAM(8);
    if (IN(9)) ln_rows((const bf16*)(ws + WS_T2B), p.out, nullptr, p.in[I_LN2G], p.in[I_LN2B], (const float*)(ws + WS_X1S), p.out + (size_t)R_SAMPLE * 1024, (const float*)(ws + WS_SLABA), 8, (const float*)(ws + WS_SLABB), 3, tid);
    for (int i = 0; i < PROBE_SYNCS; ++i) xcd_barrier(bar);
#undef IN
#undef SEAM
}

#ifndef MK_MULTI
#define MK_MULTI 0
#endif
extern "C" void kernel_launch(void* const* d_in, const int* in_sizes, int n_in, void* d_out, int out_size, void* d_ws, size_t ws_size, hipStream_t stream) {
    static int grid = 0;
    if (grid == 0) {
        if (n_in != 27 || out_size != (int)O_END || ws_size < WS_END) { fprintf(stderr, "kernel_launch: unexpected sizes n_in %d out %d ws %zu\n", n_in, out_size, ws_size); grid = -1; return; }
        int dev = 0, cus = 0, per_cu = 0;
        if (hipGetDevice(&dev) != hipSuccess || hipDeviceGetAttribute(&cus, hipDeviceAttributeMultiprocessorCount, dev) != hipSuccess) { grid = -1; return; }
        if (hipFuncSetAttribute((const void*)hymba_fwd, hipFuncAttributeMaxDynamicSharedMemorySize, LDS_BYTES) != hipSuccess) { fprintf(stderr, "kernel_launch: hipFuncSetAttribute failed\n"); grid = -1; return; }
        if (hipOccupancyMaxActiveBlocksPerMultiprocessor(&per_cu, (const void*)hymba_fwd, NTHR, LDS_BYTES) != hipSuccess || per_cu < 1) { fprintf(stderr, "kernel_launch: occupancy query says %d blocks per CU\n", per_cu); (void)hipGetLastError(); grid = -1; return; }
        grid = cus;
    }
    if (grid < 0) return;
    if (hipMemsetAsync(d_ws, 0, 16384, stream) != hipSuccess) { fprintf(stderr, "kernel_launch: memset failed\n"); return; }
    Params a{};
    for (int i = 0; i < 27; ++i) a.in[i] = (const float*)d_in[i];
    a.out = (float*)d_out; a.ws = (unsigned char*)d_ws;
#if MK_MULTI
    for (int k = 0; k < 10; ++k) { a.ph_lo = k; a.ph_hi = k + 1; hipLaunchKernelGGL(hymba_fwd, dim3(grid), dim3(NTHR), LDS_BYTES, stream, a); }
#else
    a.ph_lo = 0; a.ph_hi = 10;
    void* args[] = {&a};
    hipError_t e = hipLaunchCooperativeKernel((const void*)hymba_fwd, dim3(grid), dim3(NTHR), args, LDS_BYTES, stream);
    if (e != hipSuccess) fprintf(stderr, "cooperative launch failed: %s (grid %d)\n", hipGetErrorString(e), grid);
#endif
}
```

```cpp
#include <hip/hip_runtime.h>
#include <hip/hip_cooperative_groups.h>
#include <cstdio>
#include <cstdint>
namespace cg = cooperative_groups;
namespace pg8 {
#define PG8_LAS __attribute__((address_space(3)))
typedef unsigned short bf16_t;
typedef short bf16x8 __attribute__((ext_vector_type(8)));
typedef float f32x4 __attribute__((ext_vector_type(4)));
typedef unsigned u32x4 __attribute__((ext_vector_type(4)));
constexpr int BM = 256, BK = 64, HALF = 128, HTB = HALF * BK * 2  , STAGE_BYTES = 8 * HTB, NXCD = 8, WGM = 8;

__host__ __device__ __forceinline__ int lds_byte(int r, int c) { const int st = (r >> 4) * 2 + (c >> 5), rr = r & 15, cc = c & 31, ob = rr * 64 + cc * 2; return st * 1024 + (ob ^ (((ob >> 9) & 1) << 5)); }
__host__ __device__ __forceinline__ void stage_rc(int b, int& R, int& C) { const int st = b / 1024, sb = b % 1024, swz = sb ^ (((sb >> 9) & 1) << 5); R = (st >> 1) * 16 + swz / 64; C = (st & 1) * 32 + (swz % 64) / 2; }
__host__ __device__ __forceinline__ int perm32(int rho) { const int n = rho >> 4, i = rho & 15; return 8 * (i >> 2) + 4 * n + (i & 3); }

struct Unit { int pm, pn, koff, nt; };
struct Gemm { const bf16_t* A; const bf16_t* Bt; int M, N, K; };

struct StaticOrder {
    int nM, nN, nwg, G, c, ntf;
    __host__ __device__ void init(int M, int N, int G_, int c_, int K_ = 1024) { nM = M / BM; nN = N / BM; nwg = nM * nN; G = G_; c = c_; ntf = K_ / BK; }
    __host__ __device__ bool next(int i, Unit& u) const {
        const long L = (long)i * G + c; if (L >= nwg) return false;
        map((int)L, u); return true;
    }
    __host__ __device__ void map(int wgid, Unit& u) const {
        { const int q = nwg / NXCD, r = nwg % NXCD, xcd = wgid % NXCD, off = wgid / NXCD; wgid = (xcd < r ? xcd * (q + 1) : r * (q + 1) + (xcd - r) * q) + off; }
        const int nig = WGM * nN, gid = wgid / nig, fm = gid * WGM, gsz = (nM - fm) < WGM ? (nM - fm) : WGM;
        u.pm = fm + ((wgid % nig) % gsz); u.pn = (wgid % nig) / gsz; u.koff = 0; u.nt = ntf;
    }
    __device__ __forceinline__ void a_ready(const Unit&) const {}
    __device__ __forceinline__ void done(const Unit&) const {}
};

__device__ __forceinline__ unsigned cvt_pk_bf16(float lo, float hi) { unsigned r; asm volatile("v_cvt_pk_bf16_f32 %0, %1, %2" : "=v"(r) : "v"(lo), "v"(hi)); return r; }
typedef float f32x2 __attribute__((ext_vector_type(2)));
template <int S> struct TailOrder {
    StaticOrder so; int ntf;
    __host__ __device__ void init(int N, int G_, int c_, int K_) { so.init(16384, N, G_, c_, K_); ntf = K_ / BK; }
    __host__ __device__ bool next(int i, Unit& u) const {
        const long L = (long)i * so.G + so.c;
        if (L >= so.nwg + 16 * S) return false;
        const bool tail = L >= so.nwg;
        Unit a; so.map(tail ? 0 : (int)L, a);
        const int q = tail ? (int)(L - so.nwg) : 0, tile = q / S, sp = q - tile * S;
        u.pm = tail ? 64 + (tile >> 2) : a.pm; u.pn = tail ? (tile & 3) : a.pn; u.nt = tail ? ntf / S : ntf; u.koff = tail ? sp * (ntf / S) * BK : 0; return true;
    }
    __device__ __forceinline__ void a_ready(const Unit&) const {}
    __device__ __forceinline__ void done(const Unit&) const {}
};
struct EpiStoreBf16 {
    static constexpr bool PERM = true, AFTER_DRAIN = false;
    bf16_t* O; int ldc;
    __device__ __forceinline__ void operator()(const f32x4 (&acc)[2][2][4][2], const Unit& u, int wr, int wc, int fr, int fq) const {
        const int row0 = u.pm * BM + wr * 64 + fr, col0 = u.pn * BM + wc * 32 + 8 * fq;
#pragma unroll
        for (int ai = 0; ai < 2; ++ai)
#pragma unroll
            for (int m = 0; m < 4; ++m) { bf16_t* rowp = O + (size_t)(row0 + ai * HALF + m * 16) * ldc + col0;
#pragma unroll
                for (int bj = 0; bj < 2; ++bj) { const f32x4 v0 = acc[ai][bj][m][0], v1 = acc[ai][bj][m][1];
                    u32x4 w; w.x = cvt_pk_bf16(v0[0], v0[1]); w.y = cvt_pk_bf16(v0[2], v0[3]); w.z = cvt_pk_bf16(v1[0], v1[1]); w.w = cvt_pk_bf16(v1[2], v1[3]);
                    *(u32x4*)(rowp + bj * HALF) = w; } }
    }
};
__device__ __forceinline__ float silu_f(float g) { return g * __builtin_amdgcn_rcpf(1.0f + __expf(-g)); }
struct EpiSwiGLU {
    static constexpr bool PERM = true, AFTER_DRAIN = false;
    bf16_t* H; int ldh;
    __device__ __forceinline__ void operator()(const f32x4 (&acc)[2][2][4][2], const Unit& u, int wr, int wc, int fr, int fq) const {
        const int row0 = u.pm * BM + wr * 64 + fr, col0 = u.pn * HALF + wc * 32 + 8 * fq;
#pragma unroll
        for (int ai = 0; ai < 2; ++ai)
#pragma unroll
            for (int m = 0; m < 4; ++m) { bf16_t* rowp = H + (size_t)(row0 + ai * HALF + m * 16) * ldh + col0;
                const f32x4 g0 = acc[ai][0][m][0], g1 = acc[ai][0][m][1], u0 = acc[ai][1][m][0], u1 = acc[ai][1][m][1];
                u32x4 w; w.x = cvt_pk_bf16(silu_f(g0[0]) * u0[0], silu_f(g0[1]) * u0[1]); w.y = cvt_pk_bf16(silu_f(g0[2]) * u0[2], silu_f(g0[3]) * u0[3]);
                w.z = cvt_pk_bf16(silu_f(g1[0]) * u1[0], silu_f(g1[1]) * u1[1]); w.w = cvt_pk_bf16(silu_f(g1[2]) * u1[2], silu_f(g1[3]) * u1[3]);
                *(u32x4*)rowp = w; }
    }
};
template <bool BASE_BF16, int NS0, int KPER, long OFF0, long OFF1>
struct EpiResSlab {
    static constexpr bool PERM = false, AFTER_DRAIN = false;
    const void* base; bf16_t* out; float* wsf;
    __device__ __forceinline__ void operator()(const f32x4 (&acc)[2][2][4][2], const Unit& u, int wr, int wc, int fr, int fq) const {
        typedef unsigned u32x2v __attribute__((ext_vector_type(2)));
        constexpr int ld = 1024; constexpr float alpha = 1.189207115002721f;
        const int col0 = u.pn * BM + wc * 32 + 4 * fq;
        if (u.pm < 64) {
            const size_t t0 = (size_t)(u.pm * BM) * ld;
#pragma unroll
            for (int ai = 0; ai < 2; ++ai)
#pragma unroll
                for (int m = 0; m < 4; ++m) { const int r = ai * HALF + wr * 64 + m * 16 + fr;
#pragma unroll
                    for (int bj = 0; bj < 2; ++bj)
#pragma unroll
                        for (int n = 0; n < 2; ++n) { const size_t o = t0 + (size_t)r * ld + col0 + bj * HALF + n * 16; f32x4 bv;
                            if (BASE_BF16) { const u32x2v w = *(const u32x2v*)((const bf16_t*)base + o); bv = (f32x4){__uint_as_float(w.x << 16), __uint_as_float(w.x & 0xffff0000u), __uint_as_float(w.y << 16), __uint_as_float(w.y & 0xffff0000u)}; }
                            else bv = *(const f32x4*)((const float*)base + o);
                            const f32x4 t = bv * alpha + acc[ai][bj][m][n];
                            u32x2v ow; ow.x = cvt_pk_bf16(t[0], t[1]); ow.y = cvt_pk_bf16(t[2], t[3]); *(u32x2v*)(out + o) = ow; } }
        } else {
            const int sp = u.koff / KPER;
            float* ot = wsf + (sp < NS0 ? OFF0 + (long)sp * 1048576 : OFF1 + (long)(sp - NS0) * 1048576) + (long)((u.pm - 64) * BM) * ld;
#pragma unroll
            for (int ai = 0; ai < 2; ++ai)
#pragma unroll
                for (int m = 0; m < 4; ++m) { const int r = ai * HALF + wr * 64 + m * 16 + fr;
#pragma unroll
                    for (int bj = 0; bj < 2; ++bj)
#pragma unroll
                        for (int n = 0; n < 2; ++n) *(f32x4*)(ot + (size_t)r * ld + col0 + bj * HALF + n * 16) = acc[ai][bj][m][n]; }
        }
    }
};
template <class Epi, class Sched, bool ALIGN_EPI = false, bool SP2 = false, bool VARK = false>
__device__ __forceinline__ void gemm_phase(PG8_LAS unsigned char* lds, const Gemm g, const Sched S, const Epi E) {
    int tid_ = threadIdx.x; asm volatile("" : "+v"(tid_));
    const int tid = tid_, wid = __builtin_amdgcn_readfirstlane(tid >> 6), lane = tid & 63, wr = wid >> 2, wc = wid & 3, fr = lane & 15, fq = lane >> 4;
    const int K = g.K;
    unsigned voffA[2], voffB[2];
#pragma unroll
    for (int i = 0; i < 2; ++i) { int R, C; stage_rc(tid * 16 + i * 8192, R, C); const int Rb = Epi::PERM ? ((R & ~31) + perm32(R & 31)) : R;
        voffA[i] = (unsigned)(R * K + C) * 2u; voffB[i] = (unsigned)(Rb * K + C) * 2u; }
    const size_t kstep = (size_t)(BK * 2);
    const size_t hstep = (size_t)HALF * K * 2;
    const size_t tstep = 2 * hstep;
    const unsigned ldsw = (unsigned)wid * 1024u;
    const int aoff = lds_byte(wr * 64 + fr, fq * 8), boff = lds_byte(wc * 32 + fr, fq * 8);
#define PG8_SA(b, h) (((b) * 2 + (h)) * HTB)
#define PG8_SB(b, h) ((4 + (b) * 2 + (h)) * HTB)
#define PG8_STAGE(bufoff, gbase, voff) do { _Pragma("unroll") for (int _i = 0; _i < 2; ++_i) \
        __builtin_amdgcn_global_load_lds((const unsigned*)((const char*)(gbase) + (voff)[_i]), (PG8_LAS unsigned*)(lds + (bufoff) + ldsw + _i * 8192), 16, 0, 0); } while (0)
#define PG8_LDA(dst, b, h) do { _Pragma("unroll") for (int m = 0; m < 4; ++m) _Pragma("unroll") for (int k = 0; k < 2; ++k) dst[m][k] = *(const PG8_LAS bf16x8*)(lds + PG8_SA(b, h) + aoff + m * 2048 + k * 1024); } while (0)
#define PG8_LDB(dst, b, h) do { _Pragma("unroll") for (int n = 0; n < 2; ++n) _Pragma("unroll") for (int k = 0; k < 2; ++k) dst[n][k] = *(const PG8_LAS bf16x8*)(lds + PG8_SB(b, h) + boff + n * 2048 + k * 1024); } while (0)
#define PG8_MMA(ai, bj, At, Bt) do { __builtin_amdgcn_s_setprio(1); _Pragma("unroll") for (int m = 0; m < 4; ++m) _Pragma("unroll") for (int n = 0; n < 2; ++n) _Pragma("unroll") for (int k = 0; k < 2; ++k) \
        acc[ai][bj][m][n] = __builtin_amdgcn_mfma_f32_16x16x32_bf16(Bt[n][k], At[m][k], acc[ai][bj][m][n], 0, 0, 0); __builtin_amdgcn_s_setprio(0); } while (0)
#define PG8_WAIT_V(n) asm volatile("s_waitcnt vmcnt(" #n ")" ::: "memory")
#define PG8_WAIT_L(n) asm volatile("s_waitcnt lgkmcnt(" #n ")" ::: "memory")
#define PG8_BAR __builtin_amdgcn_s_barrier()
#define PG8_SCHED __builtin_amdgcn_sched_barrier(0)
    Unit cur, nxt; int ui = 0;
    if (!S.next(0, cur)) return;
    f32x4 acc[2][2][4][2];
#pragma unroll
    for (int a = 0; a < 2; ++a)
#pragma unroll
        for (int b = 0; b < 2; ++b)
#pragma unroll
            for (int m = 0; m < 4; ++m)
#pragma unroll
                for (int n = 0; n < 2; ++n) acc[a][b][m][n] = (f32x4){0.f, 0.f, 0.f, 0.f};
    bf16x8 At[4][2], B0[2][2], B1[2][2];
    const char* cA = (const char*)g.A + (size_t)cur.pm * tstep + (VARK ? (size_t)cur.koff * 2 : 0); const char* cB = (const char*)g.Bt + (size_t)cur.pn * tstep + (VARK ? (size_t)cur.koff * 2 : 0);
    S.a_ready(cur);
    if constexpr (SP2) {
        PG8_STAGE(PG8_SB(0, 0), cB, voffB); PG8_STAGE(PG8_SB(0, 1), cB + hstep, voffB); PG8_STAGE(PG8_SA(0, 0), cA, voffA); PG8_STAGE(PG8_SA(0, 1), cA + hstep, voffA);
        if (wr == 1) PG8_BAR;
        PG8_WAIT_V(2); PG8_BAR;
        PG8_STAGE(PG8_SB(1, 0), cB + kstep, voffB); PG8_STAGE(PG8_SA(1, 0), cA + kstep, voffA); PG8_STAGE(PG8_SB(1, 1), cB + hstep + kstep, voffB);
        PG8_WAIT_V(6); PG8_BAR;
    } else {
        PG8_STAGE(PG8_SB(0, 0), cB, voffB); PG8_STAGE(PG8_SA(0, 0), cA, voffA); PG8_STAGE(PG8_SB(0, 1), cB + hstep, voffB); PG8_STAGE(PG8_SA(0, 1), cA + hstep, voffA);
        if (wr == 1) PG8_BAR;
        PG8_WAIT_V(4); PG8_BAR;
        PG8_STAGE(PG8_SB(1, 0), cB + kstep, voffB); PG8_STAGE(PG8_SA(1, 0), cA + kstep, voffA); PG8_STAGE(PG8_SB(1, 1), cB + hstep + kstep, voffB);
        PG8_WAIT_V(6); PG8_BAR;
    }
    for (;;) {
        const bool has_next = S.next(ui + 1, nxt);
        const char* nA = has_next ? (const char*)g.A + (size_t)nxt.pm * tstep + (VARK ? (size_t)nxt.koff * 2 : 0) : cA; const char* nB = has_next ? (const char*)g.Bt + (size_t)nxt.pn * tstep + (VARK ? (size_t)nxt.koff * 2 : 0) : cB;
        const int nt = VARK ? cur.nt : K / BK;
        for (int t = 0; t < nt; t += 2) {
            const bool last = (t == nt - 2);
            const char* a1 = cA + (size_t)(t + 1) * kstep;
            const char* a2 = last ? nA : cA + (size_t)(t + 2) * kstep; const char* b2 = last ? nB : cB + (size_t)(t + 2) * kstep;
            const char* a3 = a2 + kstep; const char* b3 = b2 + kstep;
            if (last && has_next) S.a_ready(nxt);
            if constexpr (SP2) {
            PG8_LDB(B0, 0, 0); PG8_LDB(B1, 0, 1); PG8_SCHED; PG8_LDA(At, 0, 0); PG8_STAGE(PG8_SA(1, 1), a1 + hstep, voffA);
            PG8_WAIT_V(8); PG8_WAIT_L(0); PG8_BAR; PG8_MMA(0, 0, At, B0); PG8_MMA(0, 1, At, B1); PG8_BAR; PG8_SCHED;
            PG8_LDA(At, 0, 1); PG8_STAGE(PG8_SB(0, 0), b2, voffB); PG8_STAGE(PG8_SB(0, 1), b2 + hstep, voffB); PG8_STAGE(PG8_SA(0, 0), a2, voffA);
            PG8_WAIT_V(8); PG8_WAIT_L(0); PG8_BAR; PG8_MMA(1, 0, At, B0); PG8_MMA(1, 1, At, B1); PG8_BAR; PG8_SCHED;
            PG8_LDB(B0, 1, 0); PG8_LDB(B1, 1, 1); PG8_SCHED; PG8_LDA(At, 1, 0); PG8_STAGE(PG8_SA(0, 1), a2 + hstep, voffA);
            PG8_WAIT_V(8); PG8_WAIT_L(0); PG8_BAR; PG8_MMA(0, 0, At, B0); PG8_MMA(0, 1, At, B1); PG8_BAR; PG8_SCHED;
            PG8_LDA(At, 1, 1); PG8_STAGE(PG8_SB(1, 0), b3, voffB); PG8_STAGE(PG8_SB(1, 1), b3 + hstep, voffB); PG8_STAGE(PG8_SA(1, 0), a3, voffA);
            PG8_WAIT_V(8); PG8_WAIT_L(0); PG8_BAR; PG8_MMA(1, 0, At, B0); PG8_MMA(1, 1, At, B1); PG8_BAR; PG8_SCHED;
            } else {
            PG8_LDB(B0, 0, 0); PG8_SCHED; PG8_LDA(At, 0, 0); PG8_STAGE(PG8_SA(1, 1), a1 + hstep, voffA);
            PG8_WAIT_L(8); PG8_BAR; PG8_WAIT_L(0); PG8_MMA(0, 0, At, B0); PG8_BAR; PG8_SCHED;
            PG8_LDB(B1, 0, 1); PG8_STAGE(PG8_SB(0, 0), b2, voffB);
            PG8_BAR; PG8_WAIT_L(0); PG8_MMA(0, 1, At, B1); PG8_BAR;
            PG8_LDA(At, 0, 1); PG8_STAGE(PG8_SA(0, 0), a2, voffA);
            PG8_BAR; PG8_WAIT_L(0); PG8_MMA(1, 0, At, B0); PG8_BAR; PG8_SCHED;
            PG8_STAGE(PG8_SB(0, 1), b2 + hstep, voffB);
            PG8_WAIT_V(6); PG8_BAR; PG8_MMA(1, 1, At, B1); PG8_BAR;
            PG8_LDB(B0, 1, 0); PG8_SCHED; PG8_LDA(At, 1, 0); PG8_STAGE(PG8_SA(0, 1), a2 + hstep, voffA);
            PG8_WAIT_L(8); PG8_BAR; PG8_WAIT_L(0); PG8_MMA(0, 0, At, B0); PG8_BAR; PG8_SCHED;
            PG8_LDB(B1, 1, 1); PG8_STAGE(PG8_SB(1, 0), b3, voffB);
            PG8_BAR; PG8_WAIT_L(0); PG8_MMA(0, 1, At, B1); PG8_BAR;
            PG8_LDA(At, 1, 1); PG8_STAGE(PG8_SA(1, 0), a3, voffA);
            PG8_BAR; PG8_WAIT_L(0); PG8_MMA(1, 0, At, B0); PG8_BAR; PG8_SCHED;
            PG8_STAGE(PG8_SB(1, 1), b3 + hstep, voffB);
            PG8_WAIT_V(6); PG8_BAR; PG8_MMA(1, 1, At, B1); PG8_BAR;
            }
        }
        if constexpr (ALIGN_EPI) { if (wr == 0) PG8_BAR; }
        if constexpr (!Epi::AFTER_DRAIN) { E(acc, cur, wr, wc, fr, fq); S.done(cur); }
        if (!has_next) break;
#pragma unroll
        for (int a = 0; a < 2; ++a)
#pragma unroll
            for (int b = 0; b < 2; ++b)
#pragma unroll
                for (int m = 0; m < 4; ++m)
#pragma unroll
                    for (int n = 0; n < 2; ++n) acc[a][b][m][n] = (f32x4){0.f, 0.f, 0.f, 0.f};
        cur = nxt; cA = nA; cB = nB; ++ui;
        if constexpr (ALIGN_EPI) { if (wr == 1) PG8_BAR; }
    }
    PG8_WAIT_V(0);
    if constexpr (!ALIGN_EPI) { if (wr == 0) PG8_BAR; }
    PG8_BAR;
    if constexpr (Epi::AFTER_DRAIN) { E.fused(acc, cur, wr, wc, fr, fq, lds, wid, lane); S.done(cur); }
#undef PG8_SA
#undef PG8_SB
#undef PG8_STAGE
#undef PG8_LDA
#undef PG8_LDB
#undef PG8_MMA
#undef PG8_WAIT_V
#undef PG8_WAIT_L
#undef PG8_BAR
#undef PG8_SCHED
}
}

#define LAS __attribute__((address_space(3)))
typedef unsigned short bf16;
typedef unsigned v4u __attribute__((ext_vector_type(4)));
typedef unsigned v2u __attribute__((ext_vector_type(2)));
typedef float f32x4 __attribute__((ext_vector_type(4)));
typedef float f32x2 __attribute__((ext_vector_type(2)));
typedef short bf16x8 __attribute__((ext_vector_type(8)));
#define MFMA16(a, b, c) __builtin_amdgcn_mfma_f32_16x16x32_bf16((a), (b), (c), 0, 0, 0)
#define LDS_WAIT() asm volatile("s_waitcnt lgkmcnt(0)" ::: "memory")

constexpr int NTHR = 512;
constexpr int MROWS = 17920, MMAIN = 17408, R_SAMPLE = 16384, R_BLK0 = 17408;
constexpr int ZW = 2304, INW = 2312, DFF = 2816;
constexpr int ZC_K = 512, ZC_V = 640, ZC_C = 768, ZC_VM = 1280, ZC_O = 1792;
constexpr float ALPHA = 1.189207115002721f, LN_EPS = 1e-5f, KSCALE = 0.08838834764831845f;
enum { I_XP = 0, I_XS, I_CK, I_CV, I_SCONV, I_SC, I_SN, I_SM, I_META, I_WIN, I_WCONV, I_BCONV, I_WMQ, I_WMK, I_BI, I_BF, I_SINK, I_GATT, I_GML, I_WOUT, I_LN1G, I_LN1B, I_WGATE, I_WUP, I_WDOWN, I_LN2G, I_LN2B };
constexpr size_t O_YP = 0, O_YS = 16777216, O_PK = O_YS + 1048576, O_PV = O_PK + 65536, O_PCONV = O_PV + 65536, O_PC = O_PCONV + 6144, O_PN = O_PC + 262144, O_PM = O_PN + 2048,
                 O_SK = O_PM + 16, O_SV = O_SK + 2097152, O_SCONV = O_SV + 2097152, O_SC = O_SCONV + 196608, O_SN = O_SC + 8388608, O_SM = O_SN + 65536, O_END = O_SM + 512;
static_assert(O_END == 31072784, "output size");
constexpr size_t MiB = 1u << 20;
constexpr size_t WS_WIN = 1 * MiB, WS_WOUT = 6 * MiB, WS_WGU = 8 * MiB, WS_WDN = 19 * MiB, WS_WMQ = 25 * MiB, WS_WMK = 25 * MiB + 131072;
constexpr size_t WS_GATES = 26 * MiB, WS_SCAL = 27 * MiB, WS_CSUM = 27 * MiB + 32768, WS_DN = 27 * MiB + 65536, WS_NS = 27 * MiB + 524288;
constexpr size_t WS_XB = 29 * MiB, WS_DC = 29 * MiB, WS_Z = 64 * MiB, WS_QM = 143 * MiB, WS_KM = 143 * MiB + (size_t)MROWS * 512 * 2, WS_CS = 178 * MiB, WS_Y = 195 * MiB;
constexpr size_t WS_T1 = 29 * MiB, WS_X1B = 97 * MiB, WS_H = 131 * MiB, WS_X1S = 229 * MiB  , WS_SLABB = 233 * MiB  , WS_SLABA = 29 * MiB  , WS_T2B = 61 * MiB  , WS_TOKG = 249 * MiB  , WS_END = 251 * MiB;
static_assert(WS_KM + (size_t)MROWS * 512 * 2 <= WS_CS && WS_Z + (size_t)MROWS * ZW * 2 <= WS_QM && WS_H + (size_t)MMAIN * DFF * 2 <= WS_END && WS_T1 + (size_t)MMAIN * 4096 <= WS_X1B, "ws map");
constexpr int LDS_BYTES = 132096;

struct Params { const float* in[27]; float* out; unsigned char* ws; int ph_lo, ph_hi; };

__device__ __forceinline__ int row_of(int b, int pos) { return pos >= 128 ? b * 4096 + (pos - 128) : R_BLK0 + b * 128 + pos; }
__device__ __forceinline__ float bflo(unsigned w) { return __uint_as_float(w << 16); }
__device__ __forceinline__ float bfhi(unsigned w) { return __uint_as_float(w & 0xffff0000u); }
__device__ __forceinline__ float bf2f(unsigned short h) { return __uint_as_float(((unsigned)h) << 16); }
__device__ __forceinline__ unsigned pk2(float lo, float hi) { return pg8::cvt_pk_bf16(lo, hi); }
__device__ __forceinline__ unsigned short f2bf1(float x) { return (unsigned short)(pg8::cvt_pk_bf16(x, 0.f) & 0xffffu); }
__device__ __forceinline__ float wave_sum(float v) {
#pragma unroll
    for (int o = 1; o < 64; o <<= 1) v += __shfl_xor(v, o);
    return v;
}
__device__ __forceinline__ float quad_sum(float v) { v += __shfl_xor(v, 16); v += __shfl_xor(v, 32); return v; }
__device__ __forceinline__ float quad_max(float v) { v = fmaxf(v, __shfl_xor(v, 16)); v = fmaxf(v, __shfl_xor(v, 32)); return v; }
__device__ __forceinline__ float sigmoid_f(float x) { return 1.0f / (1.0f + __expf(-x)); }
__device__ __forceinline__ float logsig_f(float x) { return fminf(x, 0.f) - __logf(1.0f + __expf(-fabsf(x))); }
__device__ __forceinline__ void unpack8(const v4u r, float (&x)[8]) { x[0] = bflo(r.x); x[1] = bfhi(r.x); x[2] = bflo(r.y); x[3] = bfhi(r.y); x[4] = bflo(r.z); x[5] = bfhi(r.z); x[6] = bflo(r.w); x[7] = bfhi(r.w); }
__device__ __forceinline__ unsigned elem16(const v4u r, int e) { const unsigned w = (e >> 1) == 0 ? r.x : (e >> 1) == 1 ? r.y : (e >> 1) == 2 ? r.z : r.w; return (e & 1) ? (w >> 16) : (w & 0xffffu); }
__device__ __forceinline__ void store_vt(LAS bf16* VT, int stride, int c0, int s0, const v4u (&raw)[4]) {
#pragma unroll
    for (int e = 0; e < 8; ++e) { v2u o; o.x = elem16(raw[0], e) | (elem16(raw[1], e) << 16); o.y = elem16(raw[2], e) | (elem16(raw[3], e) << 16);
        *(LAS v2u*)(VT + (c0 + e) * stride + s0) = o; }
}
__device__ __forceinline__ bf16x8 mk8(const v2u lo, const v2u hi) { v4u t; t.x = lo.x; t.y = lo.y; t.z = hi.x; t.w = hi.y; return __builtin_bit_cast(bf16x8, t); }
__device__ __forceinline__ bf16x8 pack8(const float (&p)[8]) { v4u t; t.x = pk2(p[0], p[1]); t.y = pk2(p[2], p[3]); t.z = pk2(p[4], p[5]); t.w = pk2(p[6], p[7]); return __builtin_bit_cast(bf16x8, t); }

__device__ __forceinline__ void tr_item(const float* W, int ldw, int k0, int n0, bf16* WT, int drow0, int ldk, LAS float* scr, int lane) {
#pragma unroll
    for (int i = 0; i < 8; ++i) { const int kk = 8 * i + (lane >> 3), c4 = lane & 7; const f32x4 v = *(const f32x4*)(W + (size_t)(k0 + kk) * ldw + n0 + 4 * c4);
        LAS float* d = scr + kk * 33 + 4 * c4; d[0] = v[0]; d[1] = v[1]; d[2] = v[2]; d[3] = v[3]; }
    LDS_WAIT();
    const int c = lane & 7;
#pragma unroll
    for (int j = 0; j < 4; ++j) { const int n = (lane >> 3) + 8 * j; const LAS float* s = scr + (8 * c) * 33 + n;
        v4u o; o.x = pk2(s[0 * 33], s[1 * 33]); o.y = pk2(s[2 * 33], s[3 * 33]); o.z = pk2(s[4 * 33], s[5 * 33]); o.w = pk2(s[6 * 33], s[7 * 33]);
        *(v4u*)(WT + (size_t)(drow0 + n) * ldk + k0 + 8 * c) = o; }
    LDS_WAIT();
}
__device__ __forceinline__ void scan_vals(const float (&li)[2], const float (&lf)[2], int lane, float (&bb)[2], float (&aa)[2], float (&mx)[2]) {
    const float s = lf[0] + lf[1]; float sc = s;
#pragma unroll
    for (int o = 1; o < 64; o <<= 1) { const float n = __shfl_up(sc, o); if (lane >= o) sc += n; }
    const float excl = sc - s;
    bb[0] = excl + lf[0]; bb[1] = bb[0] + lf[1];
    aa[0] = li[0] - bb[0]; aa[1] = li[1] - bb[1];
    float pc = fmaxf(aa[0], aa[1]);
#pragma unroll
    for (int o = 1; o < 64; o <<= 1) { const float n = __shfl_up(pc, o); if (lane >= o) pc = fmaxf(pc, n); }
    float exm = __shfl_up(pc, 1); if (lane == 0) exm = -INFINITY;
    mx[0] = fmaxf(exm, aa[0]); mx[1] = fmaxf(mx[0], aa[1]);
}
constexpr int P0_I_IN = 16 * 72, P0_I_OUT = 16 * 32, P0_I_G = 16 * 88, P0_I_D = 44 * 32, P0_I_M = 32;
constexpr int P0_NIT = P0_I_IN + P0_I_OUT + 2 * P0_I_G + P0_I_D + 2 * P0_I_M;
__device__ __forceinline__ void p0_items(const Params& p, LAS unsigned char* lds, int tid, int lo, int hi, int gw, int NGW) {
    const int lane = tid & 63, wave = __builtin_amdgcn_readfirstlane(tid >> 6);
    LAS float* scr = (LAS float*)(lds + wave * 16384);
    unsigned char* ws = p.ws;
    constexpr int I_IN = P0_I_IN, I_OUT = P0_I_OUT, I_G = P0_I_G, I_D = P0_I_D, I_M = P0_I_M;
    for (int it = lo + gw; it < hi; it += NGW) {
        int r = it;
        if (r < I_IN) { const int kb = r / 72, nb = r % 72; tr_item(p.in[I_WIN], INW, 64 * kb, 32 * nb, (bf16*)(ws + WS_WIN), 32 * nb, 1024, scr, lane); continue; } r -= I_IN;
        if (r < I_OUT) { const int kb = r / 32, nb = r % 32; tr_item(p.in[I_WOUT], 1024, 64 * kb, 32 * nb, (bf16*)(ws + WS_WOUT), 32 * nb, 1024, scr, lane); continue; } r -= I_OUT;
        if (r < I_G) { const int kb = r / 88, nb = r % 88, n0 = 32 * nb; tr_item(p.in[I_WGATE], DFF, 64 * kb, n0, (bf16*)(ws + WS_WGU), (n0 >> 7) * 256 + (n0 & 127), 1024, scr, lane); continue; } r -= I_G;
        if (r < I_G) { const int kb = r / 88, nb = r % 88, n0 = 32 * nb; tr_item(p.in[I_WUP], DFF, 64 * kb, n0, (bf16*)(ws + WS_WGU), (n0 >> 7) * 256 + 128 + (n0 & 127), 1024, scr, lane); continue; } r -= I_G;
        if (r < I_D) { const int kb = r / 32, nb = r % 32; tr_item(p.in[I_WDOWN], 1024, 64 * kb, 32 * nb, (bf16*)(ws + WS_WDN), 32 * nb, DFF, scr, lane); continue; } r -= I_D;
        if (r < I_M) { const int h = r >> 3, kb = (r >> 2) & 1, nb = r & 3; tr_item(p.in[I_WMQ] + h * 16384, 128, 64 * kb, 32 * nb, (bf16*)(ws + WS_WMQ) + h * 16384, 32 * nb, 128, scr, lane); continue; } r -= I_M;
        { const int h = r >> 3, kb = (r >> 2) & 1, nb = r & 3; tr_item(p.in[I_WMK] + h * 16384, 128, 64 * kb, 32 * nb, (bf16*)(ws + WS_WMK) + h * 16384, 32 * nb, 128, scr, lane); }
    }
}
__device__ __forceinline__ void p0_load_row(const Params& p, int R, int lane, f32x4 (&v)[4]) {
    const float* src = nullptr;
    if (R < R_SAMPLE) src = p.in[I_XP] + (size_t)R * 1024;
    else if (R < R_BLK0) src = p.in[I_XS] + (size_t)(R - R_SAMPLE) * 1024;
    else { const int pp = (R - R_BLK0) & 127; if (pp >= 112) src = p.in[I_META] + (size_t)(pp - 112) * 1024; }
    if (src) {
#pragma unroll
        for (int j = 0; j < 4; ++j) v[j] = ((const f32x4*)src)[lane + 64 * j];
    } else {
#pragma unroll
        for (int j = 0; j < 4; ++j) v[j] = (f32x4){0.f, 0.f, 0.f, 0.f};
    }
}
__device__ __forceinline__ void p0_prologue(const Params& p, LAS unsigned char* lds, int tid) {
    const int lane = tid & 63, wave = __builtin_amdgcn_readfirstlane(tid >> 6);
    LAS float* scr = (LAS float*)(lds + wave * 16384);
    unsigned char* ws = p.ws;
    const int gw = (int)blockIdx.x * 8 + wave, NGW = (int)gridDim.x * 8;
    {
        f32x4 wa[4][4], wb[4][4];
        {
            LAS float* wl = (LAS float*)lds;
            for (int k = tid; k < 1024; k += NTHR) { const float* wp = p.in[I_WIN] + (size_t)k * INW + ZW; *(LAS f32x4*)(wl + k * 8) = *(const f32x4*)wp; *(LAS f32x4*)(wl + k * 8 + 4) = *(const f32x4*)(wp + 4); }
            __syncthreads();
#pragma unroll
            for (int j = 0; j < 4; ++j)
#pragma unroll
                for (int e = 0; e < 4; ++e) { const LAS float* wp = wl + (4 * lane + 256 * j + e) * 8; wa[j][e] = *(const LAS f32x4*)wp; wb[j][e] = *(const LAS f32x4*)(wp + 4); }
            __syncthreads();
        }
        bf16* Xb = (bf16*)(ws + WS_XB); float* gates = (float*)(ws + WS_GATES);
        f32x4 v[4];
        int R = gw; if (R < MROWS) p0_load_row(p, R, lane, v);
        while (R < MROWS) {
            const int Rn = R + NGW; f32x4 vn[4];
            if (Rn < MROWS) p0_load_row(p, Rn, lane, vn);
            f32x4 ga = {0.f, 0.f, 0.f, 0.f}, gb = {0.f, 0.f, 0.f, 0.f};
            unsigned long long* o8 = (unsigned long long*)(Xb + (size_t)R * 1024) + lane;
#pragma unroll
            for (int j = 0; j < 4; ++j) {
                o8[64 * j] = (unsigned long long)pk2(v[j][0], v[j][1]) | ((unsigned long long)pk2(v[j][2], v[j][3]) << 32);
#pragma unroll
                for (int e = 0; e < 4; ++e) { ga += wa[j][e] * v[j][e]; gb += wb[j][e] * v[j][e]; }
            }
#pragma unroll
            for (int e = 0; e < 4; ++e) { ga[e] = wave_sum(ga[e]); gb[e] = wave_sum(gb[e]); }
            if (lane == 0) { *(f32x4*)(gates + (size_t)R * 8) = ga; *(f32x4*)(gates + (size_t)R * 8 + 4) = gb; }
#pragma unroll
            for (int j = 0; j < 4; ++j) v[j] = vn[j];
            R = Rn;
        }
    }
    p0_items(p, lds, tid, 0, P0_I_IN, gw, NGW);
}

__device__ __forceinline__ void chunk_scan(const float* gates, const float* b_i, const float* b_f, int b, int j, int h, int lane, float (&bb)[2], float (&aa)[2], float (&mx)[2]) {
    const int R0 = row_of(b, 128 * j);
    float li[2], lf[2];
#pragma unroll
    for (int i = 0; i < 2; ++i) { const int t = 2 * lane + i, pos = 128 * j + t; const float* g = gates + (size_t)(R0 + t) * 8;
        const float ip = g[h] + b_i[h], fp = g[4 + h] + b_f[h]; const bool valid = pos >= 112;
        li[i] = valid ? ip : -INFINITY; lf[i] = valid ? logsig_f(fp) : 0.f; }
    scan_vals(li, lf, lane, bb, aa, mx);
}

template <bool SAMPLE>
__device__ __forceinline__ void unit_mlstm_a(const Params& p, LAS unsigned char* lds, int tid, int b, int j, int h) {
    const int lane = tid & 63, wave = __builtin_amdgcn_readfirstlane(tid >> 6);
    LAS bf16* CA = (LAS bf16*)lds; LAS bf16* VT = (LAS bf16*)(lds + 34816); LAS bf16* KT = (LAS bf16*)(lds + 69632);
    LAS float* wk = (LAS float*)(lds + 104448); LAS float* sB = wk + 128; LAS float* sM = sB + 64;
    unsigned char* ws = p.ws;
    const bf16* Z = (const bf16*)(ws + WS_Z); const float* gates = (const float*)(ws + WS_GATES);
    const int u = SAMPLE ? 0 : (b * 33 + j) * 4 + h, R0 = SAMPLE ? R_SAMPLE + 128 * b : row_of(b, 128 * j);
    {
        const int rg = tid >> 4, c8 = tid & 15, col = 128 * h + 8 * c8;
        float wc[4][8], bc[8];
#pragma unroll
        for (int jj = 0; jj < 4; ++jj) { const f32x4 a0 = *(const f32x4*)(p.in[I_WCONV] + jj * 512 + col), a1 = *(const f32x4*)(p.in[I_WCONV] + jj * 512 + col + 4);
            wc[jj][0] = a0[0]; wc[jj][1] = a0[1]; wc[jj][2] = a0[2]; wc[jj][3] = a0[3]; wc[jj][4] = a1[0]; wc[jj][5] = a1[1]; wc[jj][6] = a1[2]; wc[jj][7] = a1[3]; }
        { const f32x4 a0 = *(const f32x4*)(p.in[I_BCONV] + col), a1 = *(const f32x4*)(p.in[I_BCONV] + col + 4);
            bc[0] = a0[0]; bc[1] = a0[1]; bc[2] = a0[2]; bc[3] = a0[3]; bc[4] = a1[0]; bc[5] = a1[1]; bc[6] = a1[2]; bc[7] = a1[3]; }
        float x[7][8];
#pragma unroll
        for (int i = 0; i < 7; ++i) { const int lt = 4 * rg + i - 3; v4u raw = {0u, 0u, 0u, 0u};
            if (SAMPLE) {
                if (i >= 3 || (rg & 1)) { raw = *(const v4u*)(Z + (size_t)(R0 + lt) * ZW + ZC_C + col); unpack8(raw, x[i]); }
                else { const float* sp = p.in[I_SCONV] + (size_t)((16 * b + (rg >> 1)) * 3 + i) * 512 + col; const f32x4 a0 = *(const f32x4*)sp, a1 = *(const f32x4*)(sp + 4);
                    x[i][0] = a0[0]; x[i][1] = a0[1]; x[i][2] = a0[2]; x[i][3] = a0[3]; x[i][4] = a1[0]; x[i][5] = a1[1]; x[i][6] = a1[2]; x[i][7] = a1[3]; }
            } else {
                if (lt >= 0) raw = *(const v4u*)(Z + (size_t)(R0 + lt) * ZW + ZC_C + col);
                else if (j > 0) raw = *(const v4u*)(Z + (size_t)row_of(b, 128 * j + lt) * ZW + ZC_C + col);
                unpack8(raw, x[i]); } }
#pragma unroll
        for (int r = 0; r < 4; ++r) { float y[8];
#pragma unroll
            for (int e = 0; e < 8; ++e) { const float t = bc[e] + wc[0][e] * x[r][e] + wc[1][e] * x[r + 1][e] + wc[2][e] * x[r + 2][e] + wc[3][e] * x[r + 3][e]; y[e] = t * sigmoid_f(t); }
            v4u o; o.x = pk2(y[0], y[1]); o.y = pk2(y[2], y[3]); o.z = pk2(y[4], y[5]); o.w = pk2(y[6], y[7]);
            *(LAS v4u*)(CA + (4 * rg + r) * 136 + 8 * c8) = o; }
        if (!SAMPLE) { v4u raw[4];
#pragma unroll
            for (int r = 0; r < 4; ++r) raw[r] = *(const v4u*)(Z + (size_t)(R0 + 4 * rg + r) * ZW + ZC_VM + col);
            store_vt(VT, 136, 8 * c8, 4 * rg, raw); }
    }
    if (!SAMPLE && wave == 0) {
        float bb[2], aa[2], mx[2]; chunk_scan(gates, p.in[I_BI], p.in[I_BF], b, j, h, lane, bb, aa, mx);
        const float Bc = __shfl(bb[1], 63), Ml = __shfl(mx[1], 63), Mref = (Ml == -INFINITY) ? 0.f : Ml;
        wk[2 * lane] = __expf(aa[0] - Mref); wk[2 * lane + 1] = __expf(aa[1] - Mref);
        float* tg = (float*)(ws + WS_TOKG) + ((size_t)(R0 + 2 * lane) * 4 + h) * 4;
        *(f32x4*)tg = (f32x4){aa[0], bb[0], mx[0], 0.f}; *(f32x4*)(tg + 16) = (f32x4){aa[1], bb[1], mx[1], 0.f};
        if (lane == 0) *(f32x2*)((float*)(ws + WS_CSUM) + 2 * u) = (f32x2){Bc, Ml};
    }
    __syncthreads();
    const int wr = wave >> 1, wcn = wave & 1, fr = lane & 15, fq = lane >> 4;
    {
        f32x4 aq[2][4], ak[2][4];
#pragma unroll
        for (int mi = 0; mi < 2; ++mi)
#pragma unroll
            for (int ni = 0; ni < 4; ++ni) { aq[mi][ni] = (f32x4){0.f, 0.f, 0.f, 0.f}; ak[mi][ni] = (f32x4){0.f, 0.f, 0.f, 0.f}; }
        const bf16* Wq = (const bf16*)(ws + WS_WMQ) + h * 16384; const bf16* Wk = (const bf16*)(ws + WS_WMK) + h * 16384;
#pragma unroll
        for (int kk = 0; kk < 4; ++kk) { bf16x8 a[2];
#pragma unroll
            for (int mi = 0; mi < 2; ++mi) a[mi] = *(const LAS bf16x8*)(CA + (32 * wr + 16 * mi + fr) * 136 + 32 * kk + 8 * fq);
#pragma unroll
            for (int ni = 0; ni < 4; ++ni) { const int off = (64 * wcn + 16 * ni + fr) * 128 + 32 * kk + 8 * fq;
                const bf16x8 bq = *(const bf16x8*)(Wq + off), bk = *(const bf16x8*)(Wk + off);
#pragma unroll
                for (int mi = 0; mi < 2; ++mi) { aq[mi][ni] = MFMA16(a[mi], bq, aq[mi][ni]); ak[mi][ni] = MFMA16(a[mi], bk, ak[mi][ni]); } } }
        bf16* QM = (bf16*)(ws + WS_QM); bf16* KM = (bf16*)(ws + WS_KM);
#pragma unroll
        for (int mi = 0; mi < 2; ++mi)
#pragma unroll
            for (int ni = 0; ni < 4; ++ni) { const int col = 64 * wcn + 16 * ni + fr, rowb = 32 * wr + 16 * mi + 4 * fq; float kw[4];
#pragma unroll
                for (int r = 0; r < 4; ++r) { const int row = rowb + r; const size_t o = (size_t)(R0 + row) * 512 + 128 * h + col;
                    QM[o] = f2bf1(aq[mi][ni][r]); const float kv = ak[mi][ni][r] * KSCALE; KM[o] = f2bf1(kv); kw[r] = SAMPLE ? 0.f : kv * wk[row]; }
                if (!SAMPLE) { v2u o2; o2.x = pk2(kw[0], kw[1]); o2.y = pk2(kw[2], kw[3]); *(LAS v2u*)(KT + col * 136 + rowb) = o2; } }
    }
    __syncthreads();
    if (!SAMPLE) {
        f32x4 dc[2][4];
#pragma unroll
        for (int mi = 0; mi < 2; ++mi)
#pragma unroll
            for (int ni = 0; ni < 4; ++ni) dc[mi][ni] = (f32x4){0.f, 0.f, 0.f, 0.f};
#pragma unroll
        for (int kk = 0; kk < 4; ++kk) { bf16x8 a[2], bfr[4];
#pragma unroll
            for (int mi = 0; mi < 2; ++mi) a[mi] = *(const LAS bf16x8*)(VT + (32 * wr + 16 * mi + fr) * 136 + 32 * kk + 8 * fq);
#pragma unroll
            for (int ni = 0; ni < 4; ++ni) bfr[ni] = *(const LAS bf16x8*)(KT + (64 * wcn + 16 * ni + fr) * 136 + 32 * kk + 8 * fq);
#pragma unroll
            for (int mi = 0; mi < 2; ++mi)
#pragma unroll
                for (int ni = 0; ni < 4; ++ni) dc[mi][ni] = MFMA16(a[mi], bfr[ni], dc[mi][ni]); }
        float* DCu = (float*)(ws + WS_DC) + (size_t)u * 16384;
#pragma unroll
        for (int mi = 0; mi < 2; ++mi)
#pragma unroll
            for (int ni = 0; ni < 4; ++ni)
#pragma unroll
                for (int r = 0; r < 4; ++r) DCu[(32 * wr + 16 * mi + 4 * fq + r) * 128 + 64 * wcn + 16 * ni + fr] = dc[mi][ni][r];
        if (tid < 128) { float s = 0.f;
            for (int ss = 0; ss < 128; ss += 2) { const unsigned w = *(const LAS unsigned*)(KT + tid * 136 + ss); s += bflo(w) + bfhi(w); }
            ((float*)(ws + WS_DN))[u * 128 + tid] = s; }
    }
    __syncthreads();
}

__device__ __forceinline__ void attn_core(const LAS bf16* Ks, int ksd, const LAS bf16* VT, int vsd, int p0, int qi, int smin, const bf16x8 (&Qf)[2], float slope, float sink,
                                          const float* g_attn_h, bf16* yrow, bool store, int fr, int fq) {
    float sc[5][8]; float mxv = -INFINITY;
#pragma unroll
    for (int pi = 0; pi < 5; ++pi) { const int pp = p0 + pi; f32x4 s0 = {0.f, 0.f, 0.f, 0.f}, s1 = {0.f, 0.f, 0.f, 0.f};
#pragma unroll
        for (int kk = 0; kk < 2; ++kk) { const bf16x8 a0 = *(const LAS bf16x8*)(Ks + (32 * pp + fr) * ksd + 32 * kk + 8 * fq), a1 = *(const LAS bf16x8*)(Ks + (32 * pp + 16 + fr) * ksd + 32 * kk + 8 * fq);
            s0 = MFMA16(a0, Qf[kk], s0); s1 = MFMA16(a1, Qf[kk], s1); }
#pragma unroll
        for (int r = 0; r < 4; ++r) {
            { const int s = 32 * pp + 4 * fq + r, dist = 128 + qi - s; const bool ok = dist >= 0 && dist < 128 && s >= smin; const float v = ok ? s0[r] * 0.125f - slope * (float)dist : -INFINITY; sc[pi][r] = v; mxv = fmaxf(mxv, v); }
            { const int s = 32 * pp + 16 + 4 * fq + r, dist = 128 + qi - s; const bool ok = dist >= 0 && dist < 128 && s >= smin; const float v = ok ? s1[r] * 0.125f - slope * (float)dist : -INFINITY; sc[pi][4 + r] = v; mxv = fmaxf(mxv, v); }
        } }
    mxv = fmaxf(quad_max(mxv), sink);
    float psum = 0.f; f32x4 o[4];
#pragma unroll
    for (int dt = 0; dt < 4; ++dt) o[dt] = (f32x4){0.f, 0.f, 0.f, 0.f};
#pragma unroll
    for (int pi = 0; pi < 5; ++pi) { const int pp = p0 + pi; float pv[8];
#pragma unroll
        for (int i = 0; i < 8; ++i) { pv[i] = __expf(sc[pi][i] - mxv); psum += pv[i]; }
        const bf16x8 Pf = pack8(pv);
#pragma unroll
        for (int dt = 0; dt < 4; ++dt) { const LAS bf16* vp = VT + (16 * dt + fr) * vsd + 32 * pp + 4 * fq;
            o[dt] = MFMA16(mk8(*(const LAS v2u*)vp, *(const LAS v2u*)(vp + 16)), Pf, o[dt]); } }
    psum = quad_sum(psum);
    const float inv = 1.0f / (psum + __expf(sink - mxv));
    float sum = 0.f;
#pragma unroll
    for (int dt = 0; dt < 4; ++dt) { o[dt] = o[dt] * inv; sum += (o[dt][0] + o[dt][1]) + (o[dt][2] + o[dt][3]); }
    const float mean = quad_sum(sum) * (1.0f / 64.0f); float q = 0.f;
#pragma unroll
    for (int dt = 0; dt < 4; ++dt) { o[dt] = o[dt] - mean; q += (o[dt][0] * o[dt][0] + o[dt][1] * o[dt][1]) + (o[dt][2] * o[dt][2] + o[dt][3] * o[dt][3]); }
    const float rstd = 1.0f / sqrtf(quad_sum(q) * (1.0f / 64.0f) + LN_EPS);
    if (store) {
#pragma unroll
        for (int dt = 0; dt < 4; ++dt) { const int d0 = 16 * dt + 4 * fq; const f32x4 g = *(const f32x4*)(g_attn_h + d0); const f32x4 y = o[dt] * rstd * g;
            v2u w; w.x = pk2(y[0], y[1]); w.y = pk2(y[2], y[3]); *(v2u*)(yrow + d0) = w; }
    }
}
__device__ __forceinline__ void unit_attn_prompt(const Params& p, LAS unsigned char* lds, int tid, int b, int blk, int head) {
    const int lane = tid & 63, wave = __builtin_amdgcn_readfirstlane(tid >> 6), fr = lane & 15, fq = lane >> 4, kvh = head >> 2;
    LAS bf16* Ks = (LAS bf16*)lds; LAS bf16* VT = (LAS bf16*)(lds + 36864);
    const bf16* Z = (const bf16*)(p.ws + WS_Z);
    { const int key = tid >> 1, half = tid & 1, R = row_of(b, 128 * (blk - 1) + key);
#pragma unroll
      for (int i = 0; i < 4; ++i) *(LAS v4u*)(Ks + key * 72 + 32 * half + 8 * i) = *(const v4u*)(Z + (size_t)R * ZW + ZC_K + 64 * kvh + 32 * half + 8 * i); }
    { const int kg = tid >> 3, dg = tid & 7; v4u raw[4];
#pragma unroll
      for (int r = 0; r < 4; ++r) raw[r] = *(const v4u*)(Z + (size_t)row_of(b, 128 * (blk - 1) + 4 * kg + r) * ZW + ZC_V + 64 * kvh + 8 * dg);
      store_vt(VT, 264, 8 * dg, 4 * kg, raw); }
    const int qi = 16 * wave + fr, Rq = b * 4096 + 128 * (blk - 1) + qi;
    bf16x8 Qf[2];
#pragma unroll
    for (int kk = 0; kk < 2; ++kk) Qf[kk] = *(const bf16x8*)(Z + (size_t)Rq * ZW + 64 * head + 32 * kk + 8 * fq);
    __syncthreads();
    attn_core(Ks, 72, VT, 264, wave >> 1, qi, 112 - 128 * (blk - 1), Qf, exp2f(-(float)(head + 1)), p.in[I_SINK][head], p.in[I_GATT] + 64 * head,
              (bf16*)(p.ws + WS_Y) + (size_t)Rq * 1024 + 64 * head, true, fr, fq);
    __syncthreads();
}
__device__ __forceinline__ void unit_attn_sample(const Params& p, LAS unsigned char* lds, int tid, int n) {
    const int lane = tid & 63, wave = __builtin_amdgcn_readfirstlane(tid >> 6), fr = lane & 15, fq = lane >> 4, head = wave, kvh = head >> 2;
    LAS bf16* Ks = (LAS bf16*)lds; LAS bf16* VT = (LAS bf16*)(lds + 46080);
    const bf16* Z = (const bf16*)(p.ws + WS_Z);
    for (int t = tid; t < 2560; t += NTHR) { const int c = t & 7, key = (t >> 3) % 160, kv = t / 1280; v4u o = {0u, 0u, 0u, 0u};
        if (key < 128) { const float* s = p.in[I_CK] + ((size_t)(n * 128 + key) * 2 + kv) * 64 + 8 * c; const f32x4 a = *(const f32x4*)s, bq = *(const f32x4*)(s + 4);
            o.x = pk2(a[0], a[1]); o.y = pk2(a[2], a[3]); o.z = pk2(bq[0], bq[1]); o.w = pk2(bq[2], bq[3]); }
        else if (key < 136) o = *(const v4u*)(Z + (size_t)(R_SAMPLE + 8 * n + key - 128) * ZW + ZC_K + 64 * kv + 8 * c);
        *(LAS v4u*)(Ks + (kv * 160 + key) * 72 + 8 * c) = o; }
    for (int t = tid; t < 640; t += NTHR) { const int dg = t & 7, kg = (t >> 3) % 40, kv = t / 320; v4u raw[4];
#pragma unroll
        for (int r = 0; r < 4; ++r) { const int key = 4 * kg + r; v4u o = {0u, 0u, 0u, 0u};
            if (key < 128) { const float* s = p.in[I_CV] + ((size_t)(n * 128 + key) * 2 + kv) * 64 + 8 * dg; const f32x4 a = *(const f32x4*)s, bq = *(const f32x4*)(s + 4);
                o.x = pk2(a[0], a[1]); o.y = pk2(a[2], a[3]); o.z = pk2(bq[0], bq[1]); o.w = pk2(bq[2], bq[3]); }
            else if (key < 136) o = *(const v4u*)(Z + (size_t)(R_SAMPLE + 8 * n + key - 128) * ZW + ZC_V + 64 * kv + 8 * dg);
            raw[r] = o; }
        store_vt(VT + kv * 64 * 168, 168, 8 * dg, 4 * kg, raw); }
    __syncthreads();
    const int qi = fr, Rq = R_SAMPLE + 8 * n + (fr & 7);
    bf16x8 Qf[2];
#pragma unroll
    for (int kk = 0; kk < 2; ++kk) { v4u q = *(const v4u*)(Z + (size_t)Rq * ZW + 64 * head + 32 * kk + 8 * fq); if (fr >= 8) q = (v4u){0u, 0u, 0u, 0u}; Qf[kk] = __builtin_bit_cast(bf16x8, q); }
    attn_core(Ks + kvh * 160 * 72, 72, VT + kvh * 64 * 168, 168, 0, qi, 0, Qf, exp2f(-(float)(head + 1)), p.in[I_SINK][head], p.in[I_GATT] + 64 * head,
              (bf16*)(p.ws + WS_Y) + (size_t)Rq * 1024 + 64 * head, fr < 8, fr, fq);
    __syncthreads();
}

__device__ __forceinline__ void unit_mlstm_sample(const Params& p, LAS unsigned char* lds, int tid, int n, int h) {
    const int lane = tid & 63, wave = __builtin_amdgcn_readfirstlane(tid >> 6);
    LAS float* ca = (LAS float*)lds; LAS float* qs = ca + 1024; LAS float* ks = qs + 1024; LAS float* vs = ks + 1024; LAS float* hs = vs + 1024;
    LAS float* sm = hs + 1024;
    LAS float* s_li = sm, *s_lf = sm + 8, *s_ga = sm + 16, *s_mu = sm + 24, *s_wi = sm + 32, *s_mt = sm + 40, *s_wk = sm + 48, *s_nq = sm + 56, *s_Sd = sm + 64, *s_sc = sm + 128, *s_raw = sm + 136;
    const bf16* Z = (const bf16*)(p.ws + WS_Z); const float* gates = (const float*)(p.ws + WS_GATES);
    const int R0 = R_SAMPLE + 8 * n, nh = n * 4 + h;
    const int vv = tid >> 2, part = tid & 3;
    float C[32];
    {   const float* cp = p.in[I_SC] + ((size_t)nh * 128 + vv) * 128 + 32 * part;
#pragma unroll
        for (int i = 0; i < 8; ++i) { const f32x4 c4 = *(const f32x4*)(cp + 4 * i); C[4 * i] = c4[0]; C[4 * i + 1] = c4[1]; C[4 * i + 2] = c4[2]; C[4 * i + 3] = c4[3]; } }
    const float og0 = bf2f(Z[(size_t)(R0 + 2 * part) * ZW + ZC_O + 128 * h + vv]), og1 = bf2f(Z[(size_t)(R0 + 2 * part + 1) * ZW + ZC_O + 128 * h + vv]);
    {
        const int l = tid >> 6, cc = tid & 63; const size_t o = (size_t)(R0 + l) * 512 + 128 * h + 2 * cc;
        const unsigned qw = *(const unsigned*)((const bf16*)(p.ws + WS_QM) + o), kw = *(const unsigned*)((const bf16*)(p.ws + WS_KM) + o);
        const unsigned vw = *(const unsigned*)(Z + (size_t)(R0 + l) * ZW + ZC_VM + 128 * h + 2 * cc);
        qs[l * 128 + 2 * cc] = bflo(qw); qs[l * 128 + 2 * cc + 1] = bfhi(qw); ks[l * 128 + 2 * cc] = bflo(kw); ks[l * 128 + 2 * cc + 1] = bfhi(kw);
        vs[l * 128 + 2 * cc] = bflo(vw); vs[l * 128 + 2 * cc + 1] = bfhi(vw);
        if (tid < 128) ca[tid] = p.in[I_SN][(size_t)nh * 128 + tid];
        if (tid < 8) { const float* g = gates + (size_t)(R0 + tid) * 8; s_li[tid] = g[h] + p.in[I_BI][h]; s_lf[tid] = logsig_f(g[4 + h] + p.in[I_BF][h]); }
    }
    __syncthreads();
    if (tid < 8) {
        const float m_s = p.in[I_SM][nh]; float bsum = 0.f, mxr = -INFINITY, a = 0.f;
        for (int l = 0; l <= tid; ++l) { bsum += s_lf[l]; a = s_li[l] - bsum; mxr = fmaxf(mxr, a); }
        const float mu = fmaxf(m_s, mxr), mu_last = __shfl(mu, 7), mt = bsum + mu;
        s_ga[tid] = a; s_mu[tid] = mu; s_wi[tid] = __expf(m_s - mu); s_mt[tid] = mt; s_wk[tid] = __expf(a - mu_last);
        if (tid == 7) { s_sc[0] = __expf(m_s - mu_last); p.out[O_SM + nh] = mt; }
    }
    if (tid >= 64 && tid < 64 + 288) {
        const int id = (tid - 64) >> 2, pq = tid & 3; const LAS float* ap = qs + (id < 64 ? (id >> 3) : (id - 64)) * 128 + 32 * pq; const LAS float* bp = (id < 64 ? ks + (id & 7) * 128 : ca) + 32 * pq;
        float dot = 0.f;
#pragma unroll
        for (int k = 0; k < 32; ++k) dot += ap[k] * bp[k];
        dot += __shfl_xor(dot, 1); dot += __shfl_xor(dot, 2);
        if (pq == 0) s_raw[id] = dot; }
    __syncthreads();
    if (tid < 64) { const int t = tid >> 3, s2 = tid & 7; s_Sd[tid] = (s2 <= t) ? s_raw[tid] * __expf(s_ga[s2] - s_mu[t]) : 0.f; }
    else if (tid < 72) s_nq[tid - 64] = s_raw[tid];
    __syncthreads();
    {   const float decay = s_sc[0];
#pragma unroll
        for (int t = 0; t < 8; ++t) { float s = 0.f;
#pragma unroll
            for (int k = 0; k < 32; ++k) s += C[k] * qs[t * 128 + 32 * part + k];
            s += __shfl_xor(s, 1); s += __shfl_xor(s, 2);
            if ((t >> 1) == part) { float num = s_wi[t] * s, den = s_wi[t] * s_nq[t];
#pragma unroll
                for (int s2 = 0; s2 < 8; ++s2) { const float w = s_Sd[t * 8 + s2]; num += w * vs[s2 * 128 + vv]; den += w; }
                const float hval = num / fmaxf(fabsf(den), __expf(-s_mt[t]));
                hs[t * 128 + vv] = sigmoid_f((t & 1) ? og1 : og0) * hval; } }
        float wv[8];
#pragma unroll
        for (int s2 = 0; s2 < 8; ++s2) wv[s2] = s_wk[s2] * vs[s2 * 128 + vv];
        float* op = p.out + O_SC + ((size_t)nh * 128 + vv) * 128 + 32 * part;
#pragma unroll
        for (int i = 0; i < 8; ++i) { f32x4 o4;
#pragma unroll
            for (int e = 0; e < 4; ++e) { float acc = decay * C[4 * i + e];
#pragma unroll
                for (int s2 = 0; s2 < 8; ++s2) acc += wv[s2] * ks[s2 * 128 + 32 * part + 4 * i + e];
                o4[e] = acc; }
            *(f32x4*)(op + 4 * i) = o4; }
        if (tid < 128) { float acc = decay * ca[tid];
#pragma unroll
            for (int s2 = 0; s2 < 8; ++s2) acc += s_wk[s2] * ks[s2 * 128 + tid];
            p.out[O_SN + (size_t)nh * 128 + tid] = acc; }
    }
    __syncthreads();
    {
        const int t = wave; const float v0 = hs[t * 128 + 2 * lane], v1 = hs[t * 128 + 2 * lane + 1];
        const float mean = wave_sum(v0 + v1) * (1.0f / 128.0f); const float d0 = v0 - mean, d1 = v1 - mean;
        const float rstd = 1.0f / sqrtf(wave_sum(d0 * d0 + d1 * d1) * (1.0f / 128.0f) + LN_EPS);
        const float* g = p.in[I_GML] + 128 * h + 2 * lane;
        *(unsigned*)((bf16*)(p.ws + WS_Y) + (size_t)(R0 + t) * 1024 + 512 + 128 * h + 2 * lane) = pk2(d0 * rstd * g[0], d1 * rstd * g[1]);
    }
    __syncthreads();
}

__device__ __forceinline__ void copies_cache(const Params& p, int tid, int rank, int nwgs) {
    float* out = p.out; const int gt = rank * NTHR + tid, GS = nwgs * NTHR;
    constexpr int NA = 2 * 128 * 3840;
    for (int i0 = gt; i0 < NA; i0 += 4 * GS) { f32x4 v[4]; size_t dst[4];
#pragma unroll
        for (int k = 0; k < 4; ++k) { const int i = i0 + k * GS; if (i < NA) { const int which = i >= NA / 2, r = i - which * (NA / 2), n = r / 3840, o4 = r - n * 3840;
            v[k] = *(const f32x4*)(p.in[which ? I_CV : I_CK] + (size_t)n * 16384 + 1024 + 4 * o4); dst[k] = (which ? O_SV : O_SK) + (size_t)n * 16384 + 4 * o4; } }
#pragma unroll
        for (int k = 0; k < 4; ++k) if (i0 + k * GS < NA) *(f32x4*)(out + dst[k]) = v[k]; }
}
__device__ __forceinline__ void p2_copies(const Params& p, int tid) {
    const bf16* Z = (const bf16*)(p.ws + WS_Z); float* out = p.out;
    const int gt = blockIdx.x * NTHR + tid, GS = gridDim.x * NTHR;
    constexpr int B0 = 2 * 16384, B1 = B0 + 1536, B2 = B1 + 2 * 32768, NBq = B2 + 49152;
#pragma unroll 4
    for (int i = gt; i < NBq; i += GS) {
        int row, col; size_t dst;
        if (i < B0) { const int which = i >= 16384, r = i & 16383, b = r >> 12, w = (r >> 5) & 127, c4 = r & 31; row = b * 4096 + 3968 + w; col = (which ? ZC_V : ZC_K) + 4 * c4; dst = (which ? O_PV : O_PK) + (size_t)r * 4; }
        else if (i < B1) { const int r = i - B0, b = r / 384, rr = (r / 128) % 3, c4 = r & 127; row = b * 4096 + 4093 + rr; col = ZC_C + 4 * c4; dst = O_PCONV + (size_t)r * 4; }
        else if (i < B2) { const int r0 = i - B1, which = r0 >= 32768, r = r0 & 32767, n = r >> 8, w = (r >> 5) & 7, c4 = r & 31; row = R_SAMPLE + 8 * n + w; col = (which ? ZC_V : ZC_K) + 4 * c4;
            dst = (which ? O_SV : O_SK) + (size_t)n * 16384 + (size_t)(120 + w) * 128 + 4 * c4; }
        else { const int r = i - B2, n = r / 384, rr = (r / 128) % 3, c4 = r & 127; row = R_SAMPLE + 8 * n + 5 + rr; col = ZC_C + 4 * c4; dst = O_SCONV + (size_t)r * 4; }
        const v2u raw = *(const v2u*)(Z + (size_t)row * ZW + col);
        *(f32x4*)(out + dst) = (f32x4){bflo(raw.x), bfhi(raw.x), bflo(raw.y), bfhi(raw.y)};
    }
}

__device__ __forceinline__ void p3_scan(const Params& p, int tid) {
    unsigned char* ws = p.ws; const float* DC = (const float*)(ws + WS_DC); const float* DN = (const float*)(ws + WS_DN); const float* CSUM = (const float*)(ws + WS_CSUM);
    float* SCAL = (float*)(ws + WS_SCAL); bf16* CS = (bf16*)(ws + WS_CS); float* NS = (float*)(ws + WS_NS);
    for (int g = blockIdx.x * NTHR + tid; g < 131072; g += gridDim.x * NTHR) {
        const int bh = g >> 13, b = bh >> 2, h = bh & 3, e2 = g & 8191;
        float c0 = 0.f, c1 = 0.f, m = 0.f;
        for (int jb = 0; jb < 33; jb += 11) { f32x2 d[11], cs[11];
#pragma unroll
            for (int i = 0; i < 11; ++i) { const int u = (b * 33 + jb + i) * 4 + h; d[i] = *(const f32x2*)(DC + (size_t)u * 16384 + 2 * e2); cs[i] = *(const f32x2*)(CSUM + 2 * u); }
#pragma unroll
            for (int i = 0; i < 11; ++i) { const int u = (b * 33 + jb + i) * 4 + h; *(unsigned*)(CS + (size_t)u * 16384 + 2 * e2) = pk2(c0, c1);
                const float Ml = cs[i][1], mu = fmaxf(m, Ml), dec = __expf(m - mu), scl = __expf(Ml - mu);
                if (e2 == 0) *(f32x4*)(SCAL + u * 4) = (f32x4){m, dec, cs[i][0] + mu, 0.f};
                c0 = dec * c0 + scl * d[i][0]; c1 = dec * c1 + scl * d[i][1]; m = cs[i][0] + mu; } }
        *(f32x2*)(p.out + O_PC + (size_t)bh * 16384 + 2 * e2) = (f32x2){c0, c1};
        if (e2 == 0) p.out[O_PM + bh] = m;
        if (e2 < 64) { float n0 = 0.f, n1 = 0.f; m = 0.f;
            for (int jb = 0; jb < 33; jb += 11) { f32x2 d[11], cs[11];
#pragma unroll
                for (int i = 0; i < 11; ++i) { const int u = (b * 33 + jb + i) * 4 + h; d[i] = *(const f32x2*)(DN + u * 128 + 2 * e2); cs[i] = *(const f32x2*)(CSUM + 2 * u); }
#pragma unroll
                for (int i = 0; i < 11; ++i) { const int u = (b * 33 + jb + i) * 4 + h; *(f32x2*)(NS + u * 128 + 2 * e2) = (f32x2){n0, n1};
                    const float Ml = cs[i][1], mu = fmaxf(m, Ml), dec = __expf(m - mu), scl = __expf(Ml - mu);
                    n0 = dec * n0 + scl * d[i][0]; n1 = dec * n1 + scl * d[i][1]; m = cs[i][0] + mu; } }
            *(f32x2*)(p.out + O_PN + bh * 128 + 2 * e2) = (f32x2){n0, n1}; }
    }
}

__device__ __forceinline__ void unit_mlstm_b(const Params& p, LAS unsigned char* lds, int tid, int b, int j, int h) {
    const int lane = tid & 63, wave = __builtin_amdgcn_readfirstlane(tid >> 6), fr = lane & 15, fq = lane >> 4;
    LAS bf16* KMs = (LAS bf16*)lds; LAS bf16* VT = (LAS bf16*)(lds + 34816); LAS bf16* CSs = (LAS bf16*)(lds + 69632);
    LAS float* aA = (LAS float*)(lds + 104448); LAS float* bA = aA + 128; LAS float* mxA = bA + 128; LAS float* nsA = mxA + 128;
    unsigned char* ws = p.ws;
    const bf16* Z = (const bf16*)(ws + WS_Z); const bf16* QM = (const bf16*)(ws + WS_QM); const bf16* KM = (const bf16*)(ws + WS_KM); const bf16* CS = (const bf16*)(ws + WS_CS);
    const int u = (b * 33 + j) * 4 + h, R0 = b * 4096 + 128 * (j - 1);
    { const int row = tid >> 2, part = tid & 3;
#pragma unroll
      for (int i = 0; i < 4; ++i) { *(LAS v4u*)(KMs + row * 136 + 32 * part + 8 * i) = *(const v4u*)(KM + (size_t)(R0 + row) * 512 + 128 * h + 32 * part + 8 * i);
          *(LAS v4u*)(CSs + row * 136 + 32 * part + 8 * i) = *(const v4u*)(CS + (size_t)u * 16384 + row * 128 + 32 * part + 8 * i); } }
    { const int rg = tid >> 4, c8 = tid & 15; v4u raw[4];
#pragma unroll
      for (int r = 0; r < 4; ++r) raw[r] = *(const v4u*)(Z + (size_t)(R0 + 4 * rg + r) * ZW + ZC_VM + 128 * h + 8 * c8);
      store_vt(VT, 136, 8 * c8, 4 * rg, raw); }
    if (tid < 128) { const f32x4 tg = *(const f32x4*)((const float*)(ws + WS_TOKG) + ((size_t)(R0 + tid) * 4 + h) * 4); aA[tid] = tg[0]; bA[tid] = tg[1]; mxA[tid] = tg[2]; }
    else if (tid < 256) nsA[tid - 128] = ((const float*)(ws + WS_NS))[u * 128 + tid - 128];
    const float m_s = ((const float*)(ws + WS_SCAL))[u * 4];
    const int t = 16 * wave + fr, Rt = R0 + t;
    bf16x8 Qf[4]; v2u og[8];
#pragma unroll
    for (int kk = 0; kk < 4; ++kk) Qf[kk] = *(const bf16x8*)(QM + (size_t)Rt * 512 + 128 * h + 32 * kk + 8 * fq);
#pragma unroll
    for (int vt = 0; vt < 8; ++vt) og[vt] = *(const v2u*)(Z + (size_t)Rt * ZW + ZC_O + 128 * h + 16 * vt + 4 * fq);
    __syncthreads();
    const float mu_t = fmaxf(m_s, mxA[t]), w_int = __expf(m_s - mu_t), m_t = bA[t] + mu_t;
    f32x4 oi[8], oe[8];
#pragma unroll
    for (int vt = 0; vt < 8; ++vt) { oi[vt] = (f32x4){0.f, 0.f, 0.f, 0.f}; oe[vt] = (f32x4){0.f, 0.f, 0.f, 0.f}; }
    float dsum = 0.f;
    const int npair = (wave >> 1) + 1;
    for (int pp = 0; pp < npair; ++pp) {
        f32x4 s0 = {0.f, 0.f, 0.f, 0.f}, s1 = {0.f, 0.f, 0.f, 0.f};
#pragma unroll
        for (int kk = 0; kk < 4; ++kk) { const bf16x8 a0 = *(const LAS bf16x8*)(KMs + (32 * pp + fr) * 136 + 32 * kk + 8 * fq), a1 = *(const LAS bf16x8*)(KMs + (32 * pp + 16 + fr) * 136 + 32 * kk + 8 * fq);
            s0 = MFMA16(a0, Qf[kk], s0); s1 = MFMA16(a1, Qf[kk], s1); }
        float pv[8];
#pragma unroll
        for (int r = 0; r < 4; ++r) { const int sa = 32 * pp + 4 * fq + r, sb = sa + 16;
            pv[r] = (sa <= t) ? s0[r] * __expf(aA[sa] - mu_t) : 0.f; pv[4 + r] = (sb <= t) ? s1[r] * __expf(aA[sb] - mu_t) : 0.f; dsum += pv[r] + pv[4 + r]; }
        const bf16x8 Pf = pack8(pv);
#pragma unroll
        for (int vt = 0; vt < 8; ++vt) { const LAS bf16* vp = VT + (16 * vt + fr) * 136 + 32 * pp + 4 * fq;
            oi[vt] = MFMA16(mk8(*(const LAS v2u*)vp, *(const LAS v2u*)(vp + 16)), Pf, oi[vt]); }
    }
#pragma unroll
    for (int kk = 0; kk < 4; ++kk)
#pragma unroll
        for (int vt = 0; vt < 8; ++vt) oe[vt] = MFMA16(*(const LAS bf16x8*)(CSs + (16 * vt + fr) * 136 + 32 * kk + 8 * fq), Qf[kk], oe[vt]);
    float nq = 0.f;
#pragma unroll
    for (int kk = 0; kk < 4; ++kk)
#pragma unroll
        for (int jx = 0; jx < 8; ++jx) nq += nsA[32 * kk + 8 * fq + jx] * bf2f((unsigned short)Qf[kk][jx]);
    nq = quad_sum(nq); dsum = quad_sum(dsum);
    const float den = dsum + w_int * nq, inv = 1.0f / fmaxf(fabsf(den), __expf(-m_t));
    float sum = 0.f;
#pragma unroll
    for (int vt = 0; vt < 8; ++vt) { const v2u raw = og[vt];
        const float op[4] = {bflo(raw.x), bfhi(raw.x), bflo(raw.y), bfhi(raw.y)};
#pragma unroll
        for (int r = 0; r < 4; ++r) { const float hv = (oi[vt][r] + w_int * oe[vt][r]) * inv * sigmoid_f(op[r]); oi[vt][r] = hv; sum += hv; } }
    const float mean = quad_sum(sum) * (1.0f / 128.0f); float q = 0.f;
#pragma unroll
    for (int vt = 0; vt < 8; ++vt) { oi[vt] = oi[vt] - mean; q += (oi[vt][0] * oi[vt][0] + oi[vt][1] * oi[vt][1]) + (oi[vt][2] * oi[vt][2] + oi[vt][3] * oi[vt][3]); }
    const float rstd = 1.0f / sqrtf(quad_sum(q) * (1.0f / 128.0f) + LN_EPS);
    bf16* yrow = (bf16*)(ws + WS_Y) + (size_t)Rt * 1024 + 512 + 128 * h;
#pragma unroll
    for (int vt = 0; vt < 8; ++vt) { const int v0 = 16 * vt + 4 * fq; const f32x4 g = *(const f32x4*)(p.in[I_GML] + 128 * h + v0); const f32x4 y = oi[vt] * rstd * g;
        v2u w; w.x = pk2(y[0], y[1]); w.y = pk2(y[2], y[3]); *(v2u*)(yrow + v0) = w; }
    __syncthreads();
}

__device__ __forceinline__ void ln_load_bf16(const bf16* xrow, int lane, f32x4 (&v)[4]) {
#pragma unroll
    for (int jx = 0; jx < 4; ++jx) { const v2u w = ((const v2u*)xrow)[lane + 64 * jx]; v[jx] = (f32x4){bflo(w.x), bfhi(w.x), bflo(w.y), bfhi(w.y)}; }
}
__device__ __forceinline__ void ln_rows(const bf16* x, float* of, bf16* ob, const float* g, const float* bta, const float* res, float* ofS, const float* sl0, int n0, const float* sl1, int n1, int tid) {
    const int lane = tid & 63, wave = __builtin_amdgcn_readfirstlane(tid >> 6);
    const int RS = gridDim.x * 8;
    f32x4 vn[4];
    { const int R = blockIdx.x * 8 + wave; if (R < R_SAMPLE) ln_load_bf16(x + (size_t)R * 1024, lane, vn); }
    for (int R = blockIdx.x * 8 + wave; R < MMAIN; R += RS) {
        f32x4 v[4]; float s = 0.f; f32x4* orow = nullptr;
        if (R < R_SAMPLE) { if (of) orow = (f32x4*)(of + (size_t)R * 1024) + lane;
#pragma unroll
            for (int jx = 0; jx < 4; ++jx) v[jx] = vn[jx];
            if (R + RS < R_SAMPLE) ln_load_bf16(x + (size_t)(R + RS) * 1024, lane, vn);
        } else { const size_t ro = (size_t)(R - R_SAMPLE) * 1024; const f32x4* xr = (const f32x4*)(res + ro) + lane; orow = (f32x4*)(ofS + ro) + lane;
#pragma unroll
            for (int jx = 0; jx < 4; ++jx) v[jx] = xr[64 * jx] * ALPHA;
            for (int sidx = 0; sidx < n0; ++sidx) { const f32x4* sr = (const f32x4*)(sl0 + (size_t)sidx * 1048576 + ro) + lane;
#pragma unroll
                for (int jx = 0; jx < 4; ++jx) v[jx] += sr[64 * jx]; }
            for (int sidx = 0; sidx < n1; ++sidx) { const f32x4* sr = (const f32x4*)(sl1 + (size_t)sidx * 1048576 + ro) + lane;
#pragma unroll
                for (int jx = 0; jx < 4; ++jx) v[jx] += sr[64 * jx]; }
        }
#pragma unroll
        for (int jx = 0; jx < 4; ++jx) s += (v[jx][0] + v[jx][1]) + (v[jx][2] + v[jx][3]);
        const float mean = wave_sum(s) * (1.0f / 1024.0f); float s2 = 0.f;
#pragma unroll
        for (int jx = 0; jx < 4; ++jx) { v[jx] = v[jx] - mean; s2 += (v[jx][0] * v[jx][0] + v[jx][1] * v[jx][1]) + (v[jx][2] * v[jx][2] + v[jx][3] * v[jx][3]); }
        const float rstd = 1.0f / sqrtf(wave_sum(s2) * (1.0f / 1024.0f) + LN_EPS);
#pragma unroll
        for (int jx = 0; jx < 4; ++jx) { const f32x4 y = v[jx] * rstd * ((const f32x4*)g)[lane + 64 * jx] + ((const f32x4*)bta)[lane + 64 * jx];
            if (orow) orow[64 * jx] = y;
            if (ob) ((unsigned long long*)(ob + (size_t)R * 1024))[lane + 64 * jx] = (unsigned long long)pk2(y[0], y[1]) | ((unsigned long long)pk2(y[2], y[3]) << 32); }
    }
}

#define XB_TMO      128
#define XB_XCNT(j)  (256  + 64 * (j))
#define XB_XSUB(j)  (1280 + 64 * (j))
#define XB_XGEN(j)  (2304 + 64 * (j))
#define XB_TOP      3328
#define XB_TOPGEN   3392
#define XCD_BAR_WORDS 3456
#define XB_SPIN_CAP (1u << 18)

__device__ __forceinline__ unsigned xb_ld(unsigned* p)              { return __hip_atomic_load(p, __ATOMIC_RELAXED, __HIP_MEMORY_SCOPE_AGENT); }
__device__ __forceinline__ unsigned xb_add(unsigned* p, unsigned v) { return __hip_atomic_fetch_add(p, v, __ATOMIC_RELAXED, __HIP_MEMORY_SCOPE_AGENT); }
__device__ __forceinline__ unsigned xb_xcc_id() { return (unsigned)__builtin_amdgcn_s_getreg((3 << 11) | 20) & 0xFu; }
#define XB_SPIN(cond, bar) do { unsigned _sp = 0; while (cond) { __builtin_amdgcn_s_sleep(1); \
    if ((++_sp & 255u) == 0u) { if (xb_ld(&(bar)[XB_TMO])) break; if (_sp > XB_SPIN_CAP) { atomicAdd(&(bar)[XB_TMO], 1u); break; } } } } while (0)

struct XcdBarrier {
    unsigned* bar; unsigned x;
    volatile LAS unsigned* st;
};

__device__ __forceinline__ XcdBarrier xcd_barrier_post(unsigned* bar, volatile LAS unsigned* st) {
    XcdBarrier b; b.bar = bar; b.x = xb_xcc_id(); b.st = st;
    if (threadIdx.x == 0) (void)xb_add(&bar[XB_XCNT(b.x)], 1u);
    return b;
}
__device__ __forceinline__ void xcd_barrier_complete(unsigned* bar, unsigned x, unsigned& nloc, unsigned& nx) {
    const unsigned G = gridDim.x * gridDim.y * gridDim.z;
    unsigned sum, cnt, mine, sp = 0u;
    for (;;) {
        sum = 0u; cnt = 0u; mine = 0u;
#pragma unroll
        for (unsigned j = 0; j < 16; ++j) { const unsigned c = xb_ld(&bar[XB_XCNT(j)]); sum += c; cnt += (c > 0u) ? 1u : 0u; mine = (j == x) ? c : mine; }
        if (sum == G) break;
        __builtin_amdgcn_s_sleep(1);
        if ((++sp & 255u) == 0u) { if (xb_ld(&bar[XB_TMO])) break; if (sp > XB_SPIN_CAP) { atomicAdd(&bar[XB_TMO], 1u); break; } }
    }
    nloc = mine > 0u ? mine : 1u; nx = cnt > 0u ? cnt : 1u;
}

__device__ __forceinline__ void xcd_barrier(const XcdBarrier& b) {
    asm volatile("s_waitcnt vmcnt(0)" ::: "memory");
    __syncthreads();
    if (threadIdx.x == 0) {
        unsigned* bar = b.bar;
        __builtin_amdgcn_s_waitcnt(0);
        unsigned nloc = b.st[0], nx = b.st[1];
        if (nloc == 0u) { xcd_barrier_complete(bar, b.x, nloc, nx); b.st[0] = nloc; b.st[1] = nx; }
        const unsigned old = xb_add(&bar[XB_XSUB(b.x)], 1u);
        const unsigned gen = old / nloc;
        if (old + 1u == (gen + 1u) * nloc) {
            __builtin_amdgcn_fence(__ATOMIC_RELEASE, "agent");
            asm volatile("s_waitcnt vmcnt(0)" ::: "memory");
            const unsigned og = xb_add(&bar[XB_TOP], 1u);
            const unsigned tg = og / nx;
            if (og + 1u == (tg + 1u) * nx) xb_add(&bar[XB_TOPGEN], 1u);
            else XB_SPIN(xb_ld(&bar[XB_TOPGEN]) == tg, bar);
            __builtin_amdgcn_fence(__ATOMIC_ACQUIRE, "agent");
            xb_add(&bar[XB_XGEN(b.x)], 1u);
            asm volatile("s_waitcnt vmcnt(0)" ::: "memory");
        } else {
            XB_SPIN(xb_ld(&bar[XB_XGEN(b.x)]) == gen, bar);
            __builtin_amdgcn_fence(__ATOMIC_ACQUIRE, "agent");
            asm volatile("s_waitcnt vmcnt(0)" ::: "memory");
        }
    }
    __syncthreads();
}

constexpr int NU_MA = 528, NU_AP = 1024, NU_MS = 32, NU_AS = 128;
constexpr int NU_P2 = NU_MA + NU_AP + NU_MS + NU_AS;
constexpr int PROBE_SYNCS = 0; constexpr unsigned PROBE_REP = 0u;
__global__ void __launch_bounds__(NTHR, 2) hymba_fwd(Params p) {
    extern __shared__ __attribute__((aligned(16))) unsigned char lds_raw[];
    LAS unsigned char* lds = (LAS unsigned char*)lds_raw;
    cg::grid_group grid = cg::this_grid();
    const int tid = threadIdx.x;
    unsigned char* ws = p.ws;
    const int lo = p.ph_lo, hi = p.ph_hi;
    volatile LAS unsigned* MISC = (volatile LAS unsigned*)(lds + 131072);
    if (tid < 32) MISC[tid] = 0u;
    __syncthreads();
    XcdBarrier bar = xcd_barrier_post((unsigned*)ws, MISC + 8);
    if (lo < 0) grid.sync();
#define IN(k) (lo <= (k) && (k) < hi)
#define REP(k) for (int rep_ = 0; rep_ < (((PROBE_REP >> (k)) & 1u) ? 2 : 1); ++rep_, (((PROBE_REP >> (k)) & 1u) && rep_ < 2 ? xcd_barrier(bar) : (void)0))
#define SEAM(k) do { if (IN(k) && IN((k) + 1)) xcd_barrier(bar); } while (0)
    REP(0) if (IN(0)) p0_prologue(p, lds, tid);
    SEAM(0);
    REP(1) if (IN(1)) {
        pg8::Gemm g{(const pg8::bf16_t*)(ws + WS_XB), (const pg8::bf16_t*)(ws + WS_WIN), MROWS, ZW, 1024}; pg8::StaticOrder S; S.init(MROWS, ZW, (int)gridDim.x, (int)blockIdx.x, 1024);
        pg8::EpiStoreBf16 E{(pg8::bf16_t*)(ws + WS_Z), ZW};
        pg8::gemm_phase<pg8::EpiStoreBf16, pg8::StaticOrder, true, true>(lds, g, S, E);
        {
            const int G = (int)gridDim.x, c = (int)blockIdx.x, nwg = (MROWS / 256) * (ZW / 256), nmax = (nwg + G - 1) / G, mine = nwg > c ? (nwg - c + G - 1) / G : 0;
            const int first = nwg - (nmax - 1) * G;
            const int nidle = (first >= G || first < 0) ? G : G - first, rank = (first >= G || first < 0) ? c : c - first;
            if (mine < nmax || nidle == G) { int tid3 = threadIdx.x; asm volatile("" : "+v"(tid3)); p0_items(p, lds, tid3, P0_I_IN, P0_NIT, rank * 8 + (tid3 >> 6), nidle * 8); }
        }
    }
    SEAM(1);
    REP(2) if (IN(2)) {
        for (int u = blockIdx.x; u < NU_P2; u += gridDim.x) {
            int r = u; int tid = threadIdx.x; asm volatile("" : "+v"(tid));
            if (r < NU_MA) { unit_mlstm_a<false>(p, lds, tid, r / 132, (r / 4) % 33, r & 3); continue; } r -= NU_MA;
            if (r < NU_AP) { unit_attn_prompt(p, lds, tid, r >> 8, 1 + ((r >> 3) & 31), r & 7); continue; } r -= NU_AP;
            if (r < NU_MS) { unit_mlstm_a<true>(p, lds, tid, r >> 2, 0, r & 3); continue; } r -= NU_MS;
            unit_attn_sample(p, lds, tid, r);
        }
        p2_copies(p, tid);
    }
    SEAM(2);
    REP(3) if (IN(3)) p3_scan(p, tid);
    SEAM(3);
    REP(4) if (IN(4)) { for (int u = blockIdx.x; u < 1024; u += gridDim.x) { int tid2 = threadIdx.x; asm volatile("" : "+v"(tid2));
            if (u < 512) unit_mlstm_b(p, lds, tid2, u >> 7, 1 + ((u >> 2) & 31), u & 3); else unit_mlstm_sample(p, lds, tid2, (u - 512) >> 2, u & 3); } }
    SEAM(4);
    REP(5) if (IN(5)) {
        pg8::Gemm g{(const pg8::bf16_t*)(ws + WS_Y), (const pg8::bf16_t*)(ws + WS_WOUT), MMAIN, 1024, 1024}; pg8::TailOrder<4> S; S.init(1024, (int)gridDim.x, (int)blockIdx.x, 1024);
        typedef pg8::EpiResSlab<false, 4, 256, (long)(WS_SLABB / 4), (long)(WS_SLABB / 4)> Epi5; Epi5 E{(const void*)p.in[I_XP], (pg8::bf16_t*)(ws + WS_T1), (float*)ws};
        pg8::gemm_phase<Epi5, pg8::TailOrder<4>, true, true, true>(lds, g, S, E);
        { const int G = (int)gridDim.x, c = (int)blockIdx.x; int tid3 = threadIdx.x; asm volatile("" : "+v"(tid3));
          if (G > 64) { if (c >= 64) copies_cache(p, tid3, c - 64, G - 64); } else copies_cache(p, tid3, c, G); }
    }
    SEAM(5);
    if (IN(6)) ln_rows((const bf16*)(ws + WS_T1), nullptr, (bf16*)(ws + WS_X1B), p.in[I_LN1G], p.in[I_LN1B], p.in[I_XS], (float*)(ws + WS_X1S), (const float*)(ws + WS_SLABB), 4, nullptr, 0, tid);
    SEAM(6);
    REP(7) if (IN(7)) {
        pg8::Gemm g{(const pg8::bf16_t*)(ws + WS_X1B), (const pg8::bf16_t*)(ws + WS_WGU), MMAIN, 2 * DFF, 1024}; pg8::StaticOrder S; S.init(MMAIN, 2 * DFF, (int)gridDim.x, (int)blockIdx.x, 1024);
        pg8::EpiSwiGLU E{(pg8::bf16_t*)(ws + WS_H), DFF};
        pg8::gemm_phase<pg8::EpiSwiGLU, pg8::StaticOrder, true, true>(lds, g, S, E);
    }
    SEAM(7);
    REP(8) if (IN(8)) {
        pg8::Gemm g{(const pg8::bf16_t*)(ws + WS_H), (const pg8::bf16_t*)(ws + WS_WDN), MMAIN, 1024, DFF}; pg8::TailOrder<11> S; S.init(1024, (int)gridDim.x, (int)blockIdx.x, DFF);
        typedef pg8::EpiResSlab<true, 8, 256, (long)(WS_SLABA / 4), (long)(WS_SLABB / 4)> Epi8; Epi8 E{(const void*)(ws + WS_X1B), (pg8::bf16_t*)(ws + WS_T2B), (float*)ws};
        pg8::gemm_phase<Epi8, pg8::TailOrder<11>, true, true, true>(lds, g, S, E);
    }
    SEAM(8);
    if (IN(9)) ln_rows((const bf16*)(ws + WS_T2B), p.out, nullptr, p.in[I_LN2G], p.in[I_LN2B], (const float*)(ws + WS_X1S), p.out + (size_t)R_SAMPLE * 1024, (const float*)(ws + WS_SLABA), 8, (const float*)(ws + WS_SLABB), 3, tid);
    for (int i = 0; i < PROBE_SYNCS; ++i) xcd_barrier(bar);
#undef IN
#undef SEAM
}

#ifndef MK_MULTI
#define MK_MULTI 0
#endif
extern "C" void kernel_launch(void* const* d_in, const int* in_sizes, int n_in, void* d_out, int out_size, void* d_ws, size_t ws_size, hipStream_t stream) {
    static int grid = 0;
    if (grid == 0) {
        if (n_in != 27 || out_size != (int)O_END || ws_size < WS_END) { fprintf(stderr, "kernel_launch: unexpected sizes n_in %d out %d ws %zu\n", n_in, out_size, ws_size); grid = -1; return; }
        int dev = 0, cus = 0, per_cu = 0;
        if (hipGetDevice(&dev) != hipSuccess || hipDeviceGetAttribute(&cus, hipDeviceAttributeMultiprocessorCount, dev) != hipSuccess) { grid = -1; return; }
        if (hipFuncSetAttribute((const void*)hymba_fwd, hipFuncAttributeMaxDynamicSharedMemorySize, LDS_BYTES) != hipSuccess) { fprintf(stderr, "kernel_launch: hipFuncSetAttribute failed\n"); grid = -1; return; }
        if (hipOccupancyMaxActiveBlocksPerMultiprocessor(&per_cu, (const void*)hymba_fwd, NTHR, LDS_BYTES) != hipSuccess || per_cu < 1) { fprintf(stderr, "kernel_launch: occupancy query says %d blocks per CU\n", per_cu); (void)hipGetLastError(); grid = -1; return; }
        grid = cus;
    }
    if (grid < 0) return;
    if (hipMemsetAsync(d_ws, 0, 16384, stream) != hipSuccess) { fprintf(stderr, "kernel_launch: memset failed\n"); return; }
    Params a{};
    for (int i = 0; i < 27; ++i) a.in[i] = (const float*)d_in[i];
    a.out = (float*)d_out; a.ws = (unsigned char*)d_ws;
#if MK_MULTI
    for (int k = 0; k < 10; ++k) { a.ph_lo = k; a.ph_hi = k + 1; hipLaunchKernelGGL(hymba_fwd, dim3(grid), dim3(NTHR), LDS_BYTES, stream, a); }
#else
    a.ph_lo = 0; a.ph_hi = 10;
    void* args[] = {&a};
    hipError_t e = hipLaunchCooperativeKernel((const void*)hymba_fwd, dim3(grid), dim3(NTHR), args, LDS_BYTES, stream);
    if (e != hipSuccess) fprintf(stderr, "cooperative launch failed: %s (grid %d)\n", hipGetErrorString(e), grid);
#endif
}
```
